# Optimizing an MI355X kernel written in HIP

```python
import math
import jax
import jax.numpy as jnp
from jax import lax
import numpy as np

D_MODEL = 2048
BATCH = 2
SEQ = 16384
DEPTH = 1

MIX_WIDTH = D_MODEL
HEAD_DIM = 128
GDN_WIDTH = MIX_WIDTH // 2
GDN_HEADS = GDN_WIDTH // HEAD_DIM
GDN_CONV = 4
CHUNK = 64
SC_WIDTH = MIX_WIDTH - GDN_WIDTH
SC_CONV = 3
IN_COLS = 4 * GDN_WIDTH + 2 * GDN_HEADS + 3 * SC_WIDTH
IN_SPLITS = (3 * GDN_WIDTH, 4 * GDN_WIDTH, 4 * GDN_WIDTH + GDN_HEADS, 4 * GDN_WIDTH + 2 * GDN_HEADS)
N_GROUPS = 8
EXPERTS_PER_GROUP = 8
N_EXPERTS = N_GROUPS * EXPERTS_PER_GROUP
TOP_K = 2
D_EXPERT = D_MODEL // 4
MOE_BLOCK = 128
EPS = 1e-6

kernel_name = "hybrid_gdn_shortconv_hier_moe"


def rms_norm(x, w):
    xf = x.astype(jnp.float32)
    y = xf * lax.rsqrt(jnp.mean(xf * xf, axis=-1, keepdims=True) + EPS)
    return (y * w.astype(jnp.float32)).astype(x.dtype)


def l2_normalize(x):
    return x * lax.rsqrt(jnp.sum(x * x, axis=-1, keepdims=True) + EPS)


def causal_depthwise_conv(x, w):
    width = w.shape[0]
    seq = x.shape[1]
    xp = jnp.pad(x, ((0, 0), (width - 1, 0), (0, 0)))
    y = xp[:, 0:seq, :] * w[0]
    for j in range(1, width):
        y = y + xp[:, j:j + seq, :] * w[j]
    return y


def chunk_gated_delta_rule(q, k, v, g, beta):
    bsz, seq, heads, dk = q.shape
    dv = v.shape[-1]
    n_chunks = seq // CHUNK

    def chunks(t):
        t = t.reshape((bsz, n_chunks, CHUNK, heads) + t.shape[3:])
        return jnp.moveaxis(t, (1, 3), (0, 2))

    qc, kc, vc = chunks(q), chunks(k), chunks(v)
    bc = chunks(beta)
    gc = jnp.cumsum(chunks(g), axis=-1)
    idx = jnp.arange(CHUNK)
    causal = idx[:, None] >= idx[None, :]
    strict = idx[:, None] > idx[None, :]
    decay = jnp.exp(jnp.where(causal, gc[..., :, None] - gc[..., None, :], -jnp.inf))

    kb = kc * bc[..., None]
    a_mat = jnp.where(strict, jnp.einsum('nbhid,nbhjd->nbhij', kb, kc) * decay, 0.0)
    rhs = jnp.concatenate([vc * bc[..., None], kb * jnp.exp(gc)[..., None]], axis=-1)
    sol = lax.linalg.triangular_solve(a_mat, rhs, left_side=True, lower=True, unit_diagonal=True)
    u, w = sol[..., :dv], sol[..., dv:]
    attn = jnp.einsum('nbhid,nbhjd->nbhij', qc, kc) * decay
    q_dec = qc * jnp.exp(gc)[..., None]
    k_dec = kc * jnp.exp(gc[..., -1:] - gc)[..., None]
    chunk_decay = jnp.exp(gc[..., -1])

    def step(state, xs):
        u_i, w_i, q_i, k_i, a_i, d_i = xs
        v_new = u_i - jnp.einsum('bhck,bhkv->bhcv', w_i, state)
        o_i = jnp.einsum('bhck,bhkv->bhcv', q_i, state) + jnp.einsum('bhij,bhjv->bhiv', a_i, v_new)
        state = state * d_i[..., None, None] + jnp.einsum('bhck,bhcv->bhkv', k_i, v_new)
        return state, o_i

    s0 = jnp.zeros((bsz, heads, dk, dv), jnp.float32)
    _, o = lax.scan(step, s0, (u, w, q_dec, k_dec, attn, chunk_decay))
    return jnp.moveaxis(o, (0, 2), (1, 3)).reshape(bsz, seq, heads, dv)


def gated_deltanet(qkv, z, b, a, conv_w, a_log, dt_bias, norm_w):
    bsz, seq, _ = qkv.shape

    def heads(t):
        return t.reshape(bsz, seq, GDN_HEADS, HEAD_DIM)

    qkv = jax.nn.silu(causal_depthwise_conv(qkv, conv_w)).astype(jnp.float32)
    q, k, v = jnp.split(qkv, 3, axis=-1)
    q = l2_normalize(heads(q)) * (HEAD_DIM ** -0.5)
    k = l2_normalize(heads(k))
    v = heads(v)
    beta = jax.nn.sigmoid(b.astype(jnp.float32))
    g = -jnp.exp(a_log.astype(jnp.float32)) * jax.nn.softplus(a.astype(jnp.float32) + dt_bias.astype(jnp.float32))
    o = chunk_gated_delta_rule(q, k, v, g, beta)
    o = o * lax.rsqrt(jnp.mean(o * o, axis=-1, keepdims=True) + EPS) * norm_w.astype(jnp.float32)
    o = o * jax.nn.silu(heads(z).astype(jnp.float32))
    return o.reshape(bsz, seq, GDN_WIDTH).astype(z.dtype)


def short_gated_conv(bch, conv_w):
    gate_b, gate_c, hid = jnp.split(bch, 3, axis=-1)
    return gate_b * causal_depthwise_conv(gate_c * hid, conv_w)


def token_mixer(hn, w_in, conv_qkv_w, a_log, dt_bias, gdn_norm_w, conv_sc_w, w_out):
    proj = hn @ w_in
    qkv, z, b, a, sc = jnp.split(proj, IN_SPLITS, axis=-1)
    y_gdn = gated_deltanet(qkv, z, b, a, conv_qkv_w, a_log, dt_bias, gdn_norm_w)
    y_sc = short_gated_conv(sc, conv_sc_w)
    return jnp.concatenate([y_gdn, y_sc], axis=-1) @ w_out


def hierarchical_moe(hn, wg_r, bg_r, we_r, be_r, w_gate, w_up, w_down):
    bsz, seq, d = hn.shape
    x2d = hn.reshape(bsz * seq, d)
    n_tok = x2d.shape[0]
    xf = x2d.astype(jnp.float32)
    group_prob = jax.nn.softmax(xf @ wg_r.astype(jnp.float32) + bg_r.astype(jnp.float32), axis=-1)
    g_idx = jnp.argmax(group_prob, axis=-1).astype(jnp.int32)
    g_w = jnp.take_along_axis(group_prob, g_idx[:, None], axis=-1)
    e_logits = (xf @ we_r.astype(jnp.float32) + be_r.astype(jnp.float32)).reshape(n_tok, N_GROUPS, EXPERTS_PER_GROUP)
    in_group = jnp.take_along_axis(e_logits, g_idx[:, None, None], axis=1)[:, 0]
    top_p, top_i = lax.top_k(jax.nn.softmax(in_group, axis=-1), TOP_K)
    gates = g_w * top_p / jnp.sum(top_p, axis=-1, keepdims=True)
    expert_ids = g_idx[:, None] * EXPERTS_PER_GROUP + top_i.astype(jnp.int32)

    n_assign = n_tok * TOP_K
    flat_e = expert_ids.reshape(n_assign)
    flat_tok = jnp.repeat(jnp.arange(n_tok, dtype=jnp.int32), TOP_K)
    flat_gate = gates.reshape(n_assign)
    order = jnp.argsort(flat_e)
    sorted_e = flat_e[order]
    counts = jnp.bincount(flat_e, length=N_EXPERTS)
    padded = (counts + MOE_BLOCK - 1) // MOE_BLOCK * MOE_BLOCK
    pad_end = jnp.cumsum(padded)
    pad_start = pad_end - padded
    start = jnp.cumsum(counts) - counts
    dest = pad_start[sorted_e] + (jnp.arange(n_assign, dtype=jnp.int32) - start[sorted_e])
    n_blocks = -(-n_assign // MOE_BLOCK) + N_EXPERTS
    n_rows = n_blocks * MOE_BLOCK
    tok_buf = jnp.zeros((n_rows,), jnp.int32).at[dest].set(flat_tok[order])
    gate_buf = jnp.zeros((n_rows,), jnp.float32).at[dest].set(flat_gate[order])
    block_expert = jnp.minimum(
        jnp.searchsorted(pad_end, jnp.arange(n_blocks, dtype=jnp.int32) * MOE_BLOCK, side='right'),
        N_EXPERTS - 1).astype(jnp.int32)

    def run_block(args):
        tok, e, gate = args
        xb = x2d[tok]
        hid = jax.nn.silu(xb @ w_gate[e]) * (xb @ w_up[e])
        return (hid @ w_down[e]).astype(jnp.float32) * gate[:, None]

    out = lax.map(run_block, (tok_buf.reshape(n_blocks, MOE_BLOCK), block_expert,
                              gate_buf.reshape(n_blocks, MOE_BLOCK)))
    y = jax.ops.segment_sum(out.reshape(n_rows, d), tok_buf, num_segments=n_tok)
    return y.astype(hn.dtype).reshape(bsz, seq, d)


def setup_inputs(seed: int = 0) -> dict:
    key = jax.random.key(seed)
    ks = jax.random.split(key, 20)
    f32 = jnp.float32
    L = DEPTH

    def normal(k, shape, scale):
        return jax.random.normal(k, shape, f32) * scale

    def gain(k, shape):
        return 1.0 + 0.05 * jax.random.normal(k, shape, f32)

    dt = jnp.exp(jax.random.uniform(ks[5], (L, GDN_HEADS), f32, math.log(1e-3), math.log(1e-1)))
    return {
        "x": jax.random.normal(ks[0], (BATCH, SEQ, D_MODEL), f32),
        "norm1_w": gain(ks[1], (L, D_MODEL)),
        "w_in": normal(ks[2], (L, D_MODEL, IN_COLS), D_MODEL ** -0.5),
        "conv_qkv_w": normal(ks[3], (L, GDN_CONV, 3 * GDN_WIDTH), GDN_CONV ** -0.5),
        "a_log": jnp.log(jax.random.uniform(ks[4], (L, GDN_HEADS), f32, 1.0, 16.0)),
        "dt_bias": dt + jnp.log(-jnp.expm1(-dt)),
        "gdn_norm_w": gain(ks[6], (L, HEAD_DIM)),
        "conv_sc_w": normal(ks[7], (L, SC_CONV, SC_WIDTH), SC_CONV ** -0.5),
        "w_out": normal(ks[8], (L, MIX_WIDTH, D_MODEL), MIX_WIDTH ** -0.5),
        "norm2_w": gain(ks[9], (L, D_MODEL)),
        "router_group_w": normal(ks[10], (L, D_MODEL, N_GROUPS), D_MODEL ** -0.5),
        "router_group_b": normal(ks[11], (L, N_GROUPS), 0.01),
        "router_expert_w": normal(ks[12], (L, D_MODEL, N_EXPERTS), D_MODEL ** -0.5),
        "router_expert_b": normal(ks[13], (L, N_EXPERTS), 0.01),
        "w_gate": normal(ks[14], (L, N_EXPERTS, D_MODEL, D_EXPERT), D_MODEL ** -0.5),
        "w_up": normal(ks[15], (L, N_EXPERTS, D_MODEL, D_EXPERT), D_MODEL ** -0.5),
        "w_down": normal(ks[16], (L, N_EXPERTS, D_EXPERT, D_MODEL), D_EXPERT ** -0.5),
        "final_norm_w": gain(ks[17], (D_MODEL,)),
    }


def reference(x, norm1_w, w_in, conv_qkv_w, a_log, dt_bias, gdn_norm_w, conv_sc_w, w_out,
              norm2_w, router_group_w, router_group_b, router_expert_w, router_expert_b,
              w_gate, w_up, w_down, final_norm_w):
    h = x
    for i in range(DEPTH):
        h = h + token_mixer(rms_norm(h, norm1_w[i]), w_in[i], conv_qkv_w[i], a_log[i], dt_bias[i],
                            gdn_norm_w[i], conv_sc_w[i], w_out[i])
        h = h + hierarchical_moe(rms_norm(h, norm2_w[i]), router_group_w[i], router_group_b[i],
                                 router_expert_w[i], router_expert_b[i], w_gate[i], w_up[i], w_down[i])
    return rms_norm(h, final_norm_w)
```

```cpp
#include <hip/hip_runtime.h>
#include <cstdio>
#include <cstdint>
__device__ __forceinline__ int lane_id_v() { int l; asm volatile("v_mbcnt_lo_u32_b32 %0, -1, 0\n\tv_mbcnt_hi_u32_b32 %0, -1, %0" : "=v"(l)); return l; }
namespace pg8 {
#define PG8_LAS __attribute__((address_space(3)))
typedef unsigned short bf16_t;
typedef short bf16x8 __attribute__((ext_vector_type(8)));
typedef float f32x4 __attribute__((ext_vector_type(4)));
typedef unsigned u32x4 __attribute__((ext_vector_type(4)));
constexpr int BM = 256, BK = 64, HALF = 128, HTB = HALF * BK * 2  , STAGE_BYTES = 8 * HTB, NXCD = 8, WGM = 8;

__host__ __device__ __forceinline__ int lds_byte(int r, int c) { const int st = (r >> 4) * 2 + (c >> 5), rr = r & 15, cc = c & 31, ob = rr * 64 + cc * 2; return st * 1024 + (ob ^ (((ob >> 9) & 1) << 5)); }
__host__ __device__ __forceinline__ void stage_rc(int b, int& R, int& C) { const int st = b / 1024, sb = b % 1024, swz = sb ^ (((sb >> 9) & 1) << 5); R = (st >> 1) * 16 + swz / 64; C = (st & 1) * 32 + (swz % 64) / 2; }
__host__ __device__ __forceinline__ int perm32(int rho) { const int n = rho >> 4, i = rho & 15; return 8 * (i >> 2) + 4 * n + (i & 3); }

struct Unit { int pm, pn, li; };
struct Gemm { const bf16_t* A; const bf16_t* Bt; int M, N, K; int ld; };

struct StaticOrder {
    int nM, nN, nwg, G, c;
    __host__ __device__ void init(int M, int N, int G_, int c_) { nM = M / BM; nN = N / BM; nwg = nM * nN; G = G_; c = c_; }
    __host__ __device__ bool next(int i, Unit& u) const {
        const long L = (long)i * G + c; if (L >= nwg) return false;
        int wgid = (int)L; { const int q = nwg / NXCD, r = nwg % NXCD, xcd = wgid % NXCD, off = wgid / NXCD; wgid = (xcd < r ? xcd * (q + 1) : r * (q + 1) + (xcd - r) * q) + off; }
        const int nig = WGM * nN, gid = wgid / nig, fm = gid * WGM, gsz = (nM - fm) < WGM ? (nM - fm) : WGM;
        u.pm = fm + ((wgid % nig) % gsz); u.pn = (wgid % nig) / gsz; return true;
    }
    __device__ __forceinline__ void a_ready(const Unit&) const {}
    __device__ __forceinline__ void done(const Unit&) const {}
};

__device__ __forceinline__ unsigned cvt_pk_bf16(float lo, float hi) { unsigned r; asm volatile("v_cvt_pk_bf16_f32 %0, %1, %2" : "=v"(r) : "v"(lo), "v"(hi)); return r; }
typedef float f32x2 __attribute__((ext_vector_type(2)));
struct EpiBf16S {
    static constexpr bool PERM = true, AFTER_DRAIN = false; static constexpr bool LINE = true;
    bf16_t* O; int ldc; int split_cols; size_t split_stride;
    __device__ __forceinline__ void operator()(const f32x4 (&acc)[2][2][4][2], const Unit& u, int wr, int wc, int fr, int fq) const {
        const bool lo = fr < 8;
        const int row0 = u.pm * BM + wr * 64 + (fr & 7); int colt = u.pn * BM; bf16_t* base = O;
        if (split_cols) { const int t = colt / split_cols; base += (size_t)t * split_stride; colt -= t * split_cols; }
        const int col0 = colt + wc * 64 + (fr >> 3) * 32 + 8 * fq;
#pragma unroll
        for (int ai = 0; ai < 2; ++ai)
#pragma unroll
            for (int m = 0; m < 4; ++m) { bf16_t* rowp = base + (size_t)(row0 + ai * HALF + m * 16) * ldc + col0;
                u32x4 w0, w1, A, B;
                { const f32x4 v0 = acc[ai][0][m][0], v1 = acc[ai][0][m][1]; w0.x = cvt_pk_bf16(v0[0], v0[1]); w0.y = cvt_pk_bf16(v0[2], v0[3]); w0.z = cvt_pk_bf16(v1[0], v1[1]); w0.w = cvt_pk_bf16(v1[2], v1[3]); }
                { const f32x4 v0 = acc[ai][1][m][0], v1 = acc[ai][1][m][1]; w1.x = cvt_pk_bf16(v0[0], v0[1]); w1.y = cvt_pk_bf16(v0[2], v0[3]); w1.z = cvt_pk_bf16(v1[0], v1[1]); w1.w = cvt_pk_bf16(v1[2], v1[3]); }
#pragma unroll
                for (int j = 0; j < 4; ++j) { const unsigned give = lo ? w1[j] : w0[j];
                    const unsigned recv = (unsigned)__builtin_amdgcn_update_dpp(0, (int)give, 0x128  , 0xf, 0xf, false);
                    A[j] = lo ? w0[j] : recv; B[j] = lo ? recv : w1[j]; }
                *(u32x4*)rowp = A; *(u32x4*)(rowp + (size_t)8 * ldc) = B; }
    }
};
struct EpiResF32 {
    static constexpr bool PERM = false, AFTER_DRAIN = false; static constexpr bool LINE = false;
    const float* base; float* C; int ldc;
    __device__ __forceinline__ void operator()(const f32x4 (&acc)[2][2][4][2], const Unit& u, int wr, int wc, int fr, int fq) const {
        const int row0 = u.pm * BM + wr * 64 + fr, col0 = u.pn * BM + wc * 32 + 4 * fq;
#pragma unroll
        for (int ai = 0; ai < 2; ++ai) { constexpr int m0 = 0;
            f32x4 bv[4][2][2];
#pragma unroll
            for (int m = m0; m < m0 + 4; ++m) { const size_t off = (size_t)(row0 + ai * HALF + m * 16) * ldc + col0;
#pragma unroll
                for (int bj = 0; bj < 2; ++bj)
#pragma unroll
                    for (int n = 0; n < 2; ++n) bv[m][bj][n] = *(const f32x4*)(base + off + bj * HALF + n * 16); }
#pragma unroll
            for (int m = m0; m < m0 + 4; ++m) { const size_t off = (size_t)(row0 + ai * HALF + m * 16) * ldc + col0;
#pragma unroll
                for (int bj = 0; bj < 2; ++bj)
#pragma unroll
                    for (int n = 0; n < 2; ++n) *(f32x4*)(C + off + bj * HALF + n * 16) = bv[m][bj][n] + acc[ai][bj][m][n]; }
        }
    }
};
__device__ __forceinline__ float silu_f(float x) { return x * __builtin_amdgcn_rcpf(1.0f + __expf(-x)); }
struct EpiSwiGLU {
    static constexpr bool PERM = true, AFTER_DRAIN = false; static constexpr bool LINE = false;
    bf16_t* H; const PG8_LAS float* rowsc;
    __device__ __forceinline__ void operator()(const f32x4 (&acc)[2][2][4][2], const Unit& u, int wr, int wc, int fr, int fq) const {
        const int row0 = u.pm * BM + wr * 64 + fr, col0 = (u.pn & 3) * 128 + wc * 32 + 8 * fq;
        float scv[2][4];
#pragma unroll
        for (int ai = 0; ai < 2; ++ai)
#pragma unroll
            for (int m = 0; m < 4; ++m) scv[ai][m] = rowsc[u.li * BM + wr * 64 + fr + ai * HALF + m * 16];
#pragma unroll
        for (int ai = 0; ai < 2; ++ai)
#pragma unroll
            for (int m = 0; m < 4; ++m) { bf16_t* rowp = H + (size_t)(row0 + ai * HALF + m * 16) * 512 + col0; const float sc = scv[ai][m];
                const f32x4 g0 = acc[ai][0][m][0] * sc, g1 = acc[ai][0][m][1] * sc, u0 = acc[ai][1][m][0] * sc, u1 = acc[ai][1][m][1] * sc;
                f32x4 h0, h1;
#pragma unroll
                for (int j = 0; j < 4; ++j) { h0[j] = silu_f(g0[j]) * u0[j]; h1[j] = silu_f(g1[j]) * u1[j]; }
                u32x4 w; w.x = cvt_pk_bf16(h0[0], h0[1]); w.y = cvt_pk_bf16(h0[2], h0[3]); w.z = cvt_pk_bf16(h1[0], h1[1]); w.w = cvt_pk_bf16(h1[2], h1[3]);
                *(u32x4*)rowp = w; }
    }
};
struct EpiDown {
    static constexpr bool PERM = true, AFTER_DRAIN = false; static constexpr bool LINE = true;
    bf16_t* Y; const PG8_LAS float* rowgate;
    __device__ __forceinline__ void operator()(const f32x4 (&acc)[2][2][4][2], const Unit& u, int wr, int wc, int fr, int fq) const {
        const bool lo = fr < 8;
        const int row0 = u.pm * BM + wr * 64 + (fr & 7), col0 = (u.pn & 7) * 256 + wc * 64 + (fr >> 3) * 32 + 8 * fq;
        float gtv[2][4];
#pragma unroll
        for (int ai = 0; ai < 2; ++ai)
#pragma unroll
            for (int m = 0; m < 4; ++m) gtv[ai][m] = rowgate[u.li * BM + wr * 64 + fr + ai * HALF + m * 16];
#pragma unroll
        for (int ai = 0; ai < 2; ++ai)
#pragma unroll
            for (int m = 0; m < 4; ++m) { const float gt = gtv[ai][m]; bf16_t* rowp = Y + (size_t)(row0 + ai * HALF + m * 16) * 2048 + col0;
                u32x4 w0, w1, A, B;
                { const f32x4 v0 = acc[ai][0][m][0] * gt, v1 = acc[ai][0][m][1] * gt; w0.x = cvt_pk_bf16(v0[0], v0[1]); w0.y = cvt_pk_bf16(v0[2], v0[3]); w0.z = cvt_pk_bf16(v1[0], v1[1]); w0.w = cvt_pk_bf16(v1[2], v1[3]); }
                { const f32x4 v0 = acc[ai][1][m][0] * gt, v1 = acc[ai][1][m][1] * gt; w1.x = cvt_pk_bf16(v0[0], v0[1]); w1.y = cvt_pk_bf16(v0[2], v0[3]); w1.z = cvt_pk_bf16(v1[0], v1[1]); w1.w = cvt_pk_bf16(v1[2], v1[3]); }
#pragma unroll
                for (int j = 0; j < 4; ++j) { const unsigned give = lo ? w1[j] : w0[j];
                    const unsigned recv = (unsigned)__builtin_amdgcn_update_dpp(0, (int)give, 0x128  , 0xf, 0xf, false);
                    A[j] = lo ? w0[j] : recv; B[j] = lo ? recv : w1[j]; }
                *(u32x4*)rowp = A; *(u32x4*)(rowp + (size_t)8 * 2048) = B; }
    }
};
struct EpiResB16 {
    static constexpr bool PERM = true, AFTER_DRAIN = false; static constexpr bool LINE = false;
    const float* base; bf16_t* C; int ldc;
    __device__ __forceinline__ void operator()(const f32x4 (&acc)[2][2][4][2], const Unit& u, int wr, int wc, int fr, int fq) const {
        const int row0 = u.pm * BM + wr * 64 + fr, col0 = u.pn * BM + wc * 32 + 8 * fq;
#pragma unroll
        for (int ai = 0; ai < 2; ++ai) {
            f32x4 bv[4][2][2];
#pragma unroll
            for (int m = 0; m < 4; ++m) { const size_t off = (size_t)(row0 + ai * HALF + m * 16) * ldc + col0;
#pragma unroll
                for (int bj = 0; bj < 2; ++bj)
#pragma unroll
                    for (int n = 0; n < 2; ++n) bv[m][bj][n] = *(const f32x4*)(base + off + bj * HALF + n * 4); }
#pragma unroll
            for (int m = 0; m < 4; ++m) { const size_t off = (size_t)(row0 + ai * HALF + m * 16) * ldc + col0;
#pragma unroll
                for (int bj = 0; bj < 2; ++bj) { const f32x4 v0 = bv[m][bj][0] + acc[ai][bj][m][0], v1 = bv[m][bj][1] + acc[ai][bj][m][1];
                    u32x4 w; w.x = cvt_pk_bf16(v0[0], v0[1]); w.y = cvt_pk_bf16(v0[2], v0[3]); w.z = cvt_pk_bf16(v1[0], v1[1]); w.w = cvt_pk_bf16(v1[2], v1[3]);
                    *(u32x4*)(C + off + bj * HALF) = w; } }
        }
    }
};
struct EpiRes2 {
    static constexpr bool PERM = true, AFTER_DRAIN = false; static constexpr bool LINE = false;
    const bf16_t* base; bf16_t* Hb; float* ssq; int ldc;
    __device__ __forceinline__ void operator()(const f32x4 (&acc)[2][2][4][2], const Unit& u, int wr, int wc, int fr, int fq) const {
        const int row0 = u.pm * BM + wr * 64 + fr, col0 = u.pn * BM + wc * 32 + 8 * fq;
#pragma unroll
        for (int ai = 0; ai < 2; ++ai) {
            u32x4 bb[4][2];
#pragma unroll
            for (int m = 0; m < 4; ++m) { const size_t off = (size_t)(row0 + ai * HALF + m * 16) * ldc + col0;
#pragma unroll
                for (int bj = 0; bj < 2; ++bj) bb[m][bj] = *(const u32x4*)(base + off + bj * HALF); }
#pragma unroll
            for (int m = 0; m < 4; ++m) { const int row = row0 + ai * HALF + m * 16; const size_t off = (size_t)row * ldc + col0; float s = 0.f;
#pragma unroll
                for (int bj = 0; bj < 2; ++bj) { const u32x4 b = bb[m][bj]; f32x4 h0 = acc[ai][bj][m][0], h1 = acc[ai][bj][m][1];
                    h0[0] += __uint_as_float(b.x << 16); h0[1] += __uint_as_float(b.x & 0xffff0000u); h0[2] += __uint_as_float(b.y << 16); h0[3] += __uint_as_float(b.y & 0xffff0000u);
                    h1[0] += __uint_as_float(b.z << 16); h1[1] += __uint_as_float(b.z & 0xffff0000u); h1[2] += __uint_as_float(b.w << 16); h1[3] += __uint_as_float(b.w & 0xffff0000u);
                    s += ((h0[0] * h0[0] + h0[1] * h0[1]) + (h0[2] * h0[2] + h0[3] * h0[3])) + ((h1[0] * h1[0] + h1[1] * h1[1]) + (h1[2] * h1[2] + h1[3] * h1[3]));
                    u32x4 w; w.x = cvt_pk_bf16(h0[0], h0[1]); w.y = cvt_pk_bf16(h0[2], h0[3]); w.z = cvt_pk_bf16(h1[0], h1[1]); w.w = cvt_pk_bf16(h1[2], h1[3]);
                    *(u32x4*)(Hb + off + bj * HALF) = w; }
                s += __shfl_xor(s, 16); s += __shfl_xor(s, 32);
                if (fq == 0) ssq[(size_t)row * 32 + u.pn * 4 + wc] = s; }
        }
    }
};
struct EpiRouter {
    static constexpr bool PERM = false, AFTER_DRAIN = true; static constexpr bool LINE = false;
    const float* ssq; const float* rgb; const float* reb; int* eid; float* gate; float* rstd_out; int* cnt;
    __device__ __forceinline__ void fused(f32x4 (&acc)[2][2][4][2], const Unit& u, int wr, int wc, int fr, int fq, PG8_LAS unsigned char* lds, int wid, int lane) const {
        PG8_LAS float* LG = (PG8_LAS float*)lds;
        PG8_LAS int* hc = (PG8_LAS int*)(lds + 256 * 76 * 4);
        if (wid == 0) hc[lane] = 0;
        if (wc < 3) {
#pragma unroll
            for (int ai = 0; ai < 2; ++ai)
#pragma unroll
                for (int m = 0; m < 4; ++m) { const int row = ai * HALF + wr * 64 + m * 16 + fr;
#pragma unroll
                    for (int n = 0; n < 2; ++n) { const int c0 = 32 * wc + 16 * n + 4 * fq; if (c0 < 72) *(PG8_LAS f32x4*)(LG + row * 76 + c0) = acc[ai][0][m][n]; } }
        }
        asm volatile("s_waitcnt lgkmcnt(0)" ::: "memory"); __builtin_amdgcn_s_barrier(); asm volatile("" ::: "memory");
        int mycnt = 0;
        float rsl;
        { const f32x4* sp = (const f32x4*)(ssq + (size_t)(u.pm * BM + wid * 32 + (lane & 31)) * 32); f32x4 a = sp[0];
#pragma unroll
          for (int q = 1; q < 8; ++q) a += sp[q];
          rsl = rsqrtf(((a.x + a.y) + (a.z + a.w)) * (1.f / 2048.f) + 1e-6f); }
#pragma unroll 1
        for (int rr = 0; rr < 32; ++rr) {
            const int row = wid * 32 + rr, t = u.pm * BM + row;
            const float rs = __shfl(rsl, rr);
            const float gl = LG[row * 76 + (lane & 7)] * rs + rgb[lane & 7], el = LG[row * 76 + 8 + lane] * rs + reb[lane];
            float gm = gl; gm = fmaxf(gm, __shfl_xor(gm, 1)); gm = fmaxf(gm, __shfl_xor(gm, 2)); gm = fmaxf(gm, __shfl_xor(gm, 4));
            int gi = (gl == gm) ? (lane & 7) : 8; gi = min(gi, __shfl_xor(gi, 1)); gi = min(gi, __shfl_xor(gi, 2)); gi = min(gi, __shfl_xor(gi, 4));
            float gsum = __expf(gl - gm); gsum += __shfl_xor(gsum, 1); gsum += __shfl_xor(gsum, 2); gsum += __shfl_xor(gsum, 4);
            gi = __builtin_amdgcn_readfirstlane(gi); const float gwt = 1.0f / gsum;
            const float v = __shfl(el, gi * 8 + (lane & 7));
            float m1 = v; m1 = fmaxf(m1, __shfl_xor(m1, 1)); m1 = fmaxf(m1, __shfl_xor(m1, 2)); m1 = fmaxf(m1, __shfl_xor(m1, 4));
            int i1 = (v == m1) ? (lane & 7) : 8; i1 = min(i1, __shfl_xor(i1, 1)); i1 = min(i1, __shfl_xor(i1, 2)); i1 = min(i1, __shfl_xor(i1, 4));
            const float v2 = ((lane & 7) == i1) ? -3.0e38f : v;
            float m2 = v2; m2 = fmaxf(m2, __shfl_xor(m2, 1)); m2 = fmaxf(m2, __shfl_xor(m2, 2)); m2 = fmaxf(m2, __shfl_xor(m2, 4));
            int i2 = (v2 == m2) ? (lane & 7) : 8; i2 = min(i2, __shfl_xor(i2, 1)); i2 = min(i2, __shfl_xor(i2, 2)); i2 = min(i2, __shfl_xor(i2, 4));
            const float e2 = __expf(m2 - m1), inv = 1.0f / (1.0f + e2);
            const int e_a = gi * 8 + __builtin_amdgcn_readfirstlane(i1), e_b = gi * 8 + __builtin_amdgcn_readfirstlane(i2);
            mycnt += (lane == e_a) + (lane == e_b);
            if (lane == 0) { eid[t * 2] = e_a; eid[t * 2 + 1] = e_b; gate[t * 2] = gwt * inv; gate[t * 2 + 1] = gwt * e2 * inv; rstd_out[t] = rs; }
        }
        atomicAdd((int*)&hc[lane], mycnt);
        asm volatile("s_waitcnt lgkmcnt(0)" ::: "memory"); __builtin_amdgcn_s_barrier(); asm volatile("" ::: "memory");
        if (wid == 0) cnt[u.pm * 64 + lane] = hc[lane];
    }
};
struct MoeOrder {
    const PG8_LAS int* tile_e; int ntiles, NT, G, c, skip_e, skip_tiles;
    __device__ __forceinline__ bool next(int i, Unit& u) const {
        int r, nt;
        if ((G & 7) == 0) { const int x = c & 7, rank = c >> 3, W = G >> 3; const int t0 = (int)((long)ntiles * x / 8), t1 = (int)((long)ntiles * (x + 1) / 8);
            const int j = i * W + rank; if (j >= (t1 - t0) * NT) return false; r = t0 + j / NT; nt = j % NT; }
        else { const long L = (long)i * G + c; if (L >= (long)ntiles * NT) return false; r = (int)(L / NT); nt = (int)(L % NT); }
        const int e = __builtin_amdgcn_readfirstlane(tile_e[r]); u.pm = r; u.pn = e * NT + nt + (e >= skip_e ? skip_tiles : 0); u.li = i; return true;
    }
    __device__ __forceinline__ void a_ready(const Unit&) const {}
    __device__ __forceinline__ void done(const Unit&) const {}
};
template <class Epi, class Sched, bool ALIGN_EPI = false, bool SP2 = false, bool GATHER = false>
__device__ __forceinline__ void gemm_phase(PG8_LAS unsigned char* lds, const Gemm g, const Sched& S, const Epi& E, const int wid, const PG8_LAS int* rowidx = nullptr) {
    const int lane = lane_id_v(), tid = wid * 64 + lane, wr = wid >> 2, wc = wid & 3, fr = lane & 15, fq = lane >> 4;
    const int K = g.K, nt = K / BK, LD = g.ld ? g.ld : g.K;
    unsigned voffA[2], voffB[2];
#pragma unroll
    for (int i = 0; i < 2; ++i) { int R, C; stage_rc(tid * 16 + i * 8192, R, C); const int Rb = Epi::PERM ? ((Epi::LINE ? 2 : 1) * (R & ~31) + perm32(R & 31)) : R;
        voffA[i] = (unsigned)(R * LD + C) * 2u; voffB[i] = (unsigned)(Rb * LD + C) * 2u; }
    int gR[2], gC[2];
#pragma unroll
    for (int i = 0; i < 2; ++i) stage_rc(tid * 16 + i * 8192, gR[i], gC[i]);
    unsigned offC[2][2], offN[2][2];
    const size_t kstep = (size_t)(BK * 2);
    const size_t hstep = (size_t)HALF * LD * 2; const size_t hstepA = GATHER ? 0 : hstep;
    const size_t hstepB = Epi::LINE ? (size_t)32 * LD * 2 : hstep;
    const size_t tstep = 2 * hstep;
    const unsigned ldsw = (unsigned)wid * 1024u;
    const int aoff = lds_byte(wr * 64 + fr, fq * 8), boff = lds_byte(wc * 32 + fr, fq * 8);
#define PG8_SA(b, h) (((b) * 2 + (h)) * HTB)
#define PG8_SB(b, h) ((4 + (b) * 2 + (h)) * HTB)
#define PG8_STAGE(bufoff, gbase, voff) do { _Pragma("unroll") for (int _i = 0; _i < 2; ++_i) \
        __builtin_amdgcn_global_load_lds((const unsigned*)((const char*)(gbase) + (voff)[_i]), (PG8_LAS unsigned*)(lds + (bufoff) + ldsw + _i * 8192), 16, 0, 0); } while (0)
#define PG8_LDA(dst, b, h) do { _Pragma("unroll") for (int m = 0; m < 4; ++m) _Pragma("unroll") for (int k = 0; k < 2; ++k) dst[m][k] = *(const PG8_LAS bf16x8*)(lds + PG8_SA(b, h) + aoff + m * 2048 + k * 1024); } while (0)
#define PG8_LDB(dst, b, h) do { _Pragma("unroll") for (int n = 0; n < 2; ++n) _Pragma("unroll") for (int k = 0; k < 2; ++k) dst[n][k] = *(const PG8_LAS bf16x8*)(lds + PG8_SB(b, h) + boff + n * 2048 + k * 1024); } while (0)
#define PG8_MMA(ai, bj, At, Bt) do { __builtin_amdgcn_s_setprio(1); _Pragma("unroll") for (int m = 0; m < 4; ++m) _Pragma("unroll") for (int n = 0; n < 2; ++n) _Pragma("unroll") for (int k = 0; k < 2; ++k) \
        acc[ai][bj][m][n] = __builtin_amdgcn_mfma_f32_16x16x32_bf16(Bt[n][k], At[m][k], acc[ai][bj][m][n], 0, 0, 0); __builtin_amdgcn_s_setprio(0); } while (0)
#define PG8_WAIT_V(n) asm volatile("s_waitcnt vmcnt(" #n ")" ::: "memory")
#define PG8_WAIT_L(n) asm volatile("s_waitcnt lgkmcnt(" #n ")" ::: "memory")
#define PG8_BAR __builtin_amdgcn_s_barrier()
#define PG8_SCHED __builtin_amdgcn_sched_barrier(0)
    Unit cur, nxt; int ui = 0;
    if (!S.next(0, cur)) return;
    f32x4 acc[2][2][4][2];
#pragma unroll
    for (int a = 0; a < 2; ++a)
#pragma unroll
        for (int b = 0; b < 2; ++b)
#pragma unroll
            for (int m = 0; m < 4; ++m)
#pragma unroll
                for (int n = 0; n < 2; ++n) acc[a][b][m][n] = (f32x4){0.f, 0.f, 0.f, 0.f};
    bf16x8 At[4][2], B0[2][2], B1[2][2];
    const char* cA = GATHER ? (const char*)g.A : (const char*)g.A + (size_t)cur.pm * tstep; const char* cB = (const char*)g.Bt + (size_t)cur.pn * tstep;
#pragma unroll
    for (int h = 0; h < 2; ++h)
#pragma unroll
        for (int i = 0; i < 2; ++i) { offC[h][i] = GATHER ? (unsigned)rowidx[h * HALF + gR[i]] * (unsigned)(LD * 2) + (unsigned)(gC[i] * 2) : voffA[i]; offN[h][i] = offC[h][i]; }
    S.a_ready(cur);
    if constexpr (SP2) {
        PG8_STAGE(PG8_SB(0, 0), cB, voffB); PG8_STAGE(PG8_SB(0, 1), cB + hstepB, voffB); PG8_STAGE(PG8_SA(0, 0), cA, offC[0]); PG8_STAGE(PG8_SA(0, 1), cA + hstepA, offC[1]);
        if (wr == 1) PG8_BAR;
        PG8_WAIT_V(2); PG8_BAR;
        PG8_STAGE(PG8_SB(1, 0), cB + kstep, voffB); PG8_STAGE(PG8_SA(1, 0), cA + kstep, offC[0]); PG8_STAGE(PG8_SB(1, 1), cB + hstepB + kstep, voffB);
        PG8_WAIT_V(6); PG8_BAR;
    } else {
        PG8_STAGE(PG8_SB(0, 0), cB, voffB); PG8_STAGE(PG8_SA(0, 0), cA, offC[0]); PG8_STAGE(PG8_SB(0, 1), cB + hstepB, voffB); PG8_STAGE(PG8_SA(0, 1), cA + hstepA, offC[1]);
        if (wr == 1) PG8_BAR;
        PG8_WAIT_V(4); PG8_BAR;
        PG8_STAGE(PG8_SB(1, 0), cB + kstep, voffB); PG8_STAGE(PG8_SA(1, 0), cA + kstep, offC[0]); PG8_STAGE(PG8_SB(1, 1), cB + hstepB + kstep, voffB);
        PG8_WAIT_V(6); PG8_BAR;
    }
    for (;;) {
        const bool has_next = S.next(ui + 1, nxt);
        const char* nA = (has_next && !GATHER) ? (const char*)g.A + (size_t)nxt.pm * tstep : cA;
        if (GATHER && has_next) {
#pragma unroll
            for (int h = 0; h < 2; ++h)
#pragma unroll
                for (int i = 0; i < 2; ++i) offN[h][i] = (unsigned)rowidx[(ui + 1) * BM + h * HALF + gR[i]] * (unsigned)(LD * 2) + (unsigned)(gC[i] * 2);
        } const char* nB = has_next ? (const char*)g.Bt + (size_t)nxt.pn * tstep : cB;
        for (int t = 0; t < nt; t += 2) {
            const bool last = (t == nt - 2);
            const char* a1 = cA + (size_t)(t + 1) * kstep;
            const char* a2 = last ? nA : cA + (size_t)(t + 2) * kstep; const char* b2 = last ? nB : cB + (size_t)(t + 2) * kstep;
            const char* a3 = a2 + kstep; const char* b3 = b2 + kstep;
            unsigned o2[2][2];
#pragma unroll
            for (int h = 0; h < 2; ++h)
#pragma unroll
                for (int i = 0; i < 2; ++i) o2[h][i] = last ? offN[h][i] : offC[h][i];
            if (last && has_next) S.a_ready(nxt);
            if constexpr (SP2) {
            PG8_LDB(B0, 0, 0); PG8_LDB(B1, 0, 1); PG8_SCHED; PG8_LDA(At, 0, 0); PG8_STAGE(PG8_SA(1, 1), a1 + hstepA, offC[1]);
            PG8_WAIT_V(8); PG8_WAIT_L(0); PG8_BAR; PG8_MMA(0, 0, At, B0); PG8_MMA(0, 1, At, B1); PG8_BAR; PG8_SCHED;
            PG8_LDA(At, 0, 1); PG8_STAGE(PG8_SB(0, 0), b2, voffB); PG8_STAGE(PG8_SB(0, 1), b2 + hstepB, voffB); PG8_STAGE(PG8_SA(0, 0), a2, o2[0]);
            PG8_WAIT_V(8); PG8_WAIT_L(0); PG8_BAR; PG8_MMA(1, 0, At, B0); PG8_MMA(1, 1, At, B1); PG8_BAR; PG8_SCHED;
            PG8_LDB(B0, 1, 0); PG8_LDB(B1, 1, 1); PG8_SCHED; PG8_LDA(At, 1, 0); PG8_STAGE(PG8_SA(0, 1), a2 + hstepA, o2[1]);
            PG8_WAIT_V(8); PG8_WAIT_L(0); PG8_BAR; PG8_MMA(0, 0, At, B0); PG8_MMA(0, 1, At, B1); PG8_BAR; PG8_SCHED;
            PG8_LDA(At, 1, 1); PG8_STAGE(PG8_SB(1, 0), b3, voffB); PG8_STAGE(PG8_SB(1, 1), b3 + hstepB, voffB); PG8_STAGE(PG8_SA(1, 0), a3, o2[0]);
            PG8_WAIT_V(8); PG8_WAIT_L(0); PG8_BAR; PG8_MMA(1, 0, At, B0); PG8_MMA(1, 1, At, B1); PG8_BAR; PG8_SCHED;
            } else {
            PG8_LDB(B0, 0, 0); PG8_SCHED; PG8_LDA(At, 0, 0); PG8_STAGE(PG8_SA(1, 1), a1 + hstepA, offC[1]);
            PG8_WAIT_L(8); PG8_BAR; PG8_WAIT_L(0); PG8_MMA(0, 0, At, B0); PG8_BAR; PG8_SCHED;
            PG8_LDB(B1, 0, 1); PG8_STAGE(PG8_SB(0, 0), b2, voffB);
            PG8_BAR; PG8_WAIT_L(0); PG8_MMA(0, 1, At, B1); PG8_BAR;
            PG8_LDA(At, 0, 1); PG8_STAGE(PG8_SA(0, 0), a2, o2[0]);
            PG8_BAR; PG8_WAIT_L(0); PG8_MMA(1, 0, At, B0); PG8_BAR; PG8_SCHED;
            PG8_STAGE(PG8_SB(0, 1), b2 + hstepB, voffB);
            PG8_WAIT_V(6); PG8_BAR; PG8_MMA(1, 1, At, B1); PG8_BAR;
            PG8_LDB(B0, 1, 0); PG8_SCHED; PG8_LDA(At, 1, 0); PG8_STAGE(PG8_SA(0, 1), a2 + hstepA, o2[1]);
            PG8_WAIT_L(8); PG8_BAR; PG8_WAIT_L(0); PG8_MMA(0, 0, At, B0); PG8_BAR; PG8_SCHED;
            PG8_LDB(B1, 1, 1); PG8_STAGE(PG8_SB(1, 0), b3, voffB);
            PG8_BAR; PG8_WAIT_L(0); PG8_MMA(0, 1, At, B1); PG8_BAR;
            PG8_LDA(At, 1, 1); PG8_STAGE(PG8_SA(1, 0), a3, o2[0]);
            PG8_BAR; PG8_WAIT_L(0); PG8_MMA(1, 0, At, B0); PG8_BAR; PG8_SCHED;
            PG8_STAGE(PG8_SB(1, 1), b3 + hstepB, voffB);
            PG8_WAIT_V(6); PG8_BAR; PG8_MMA(1, 1, At, B1); PG8_BAR;
            }
        }
        if constexpr (ALIGN_EPI) { if (wr == 0) PG8_BAR; }
        if constexpr (!Epi::AFTER_DRAIN) { E(acc, cur, wr, wc, fr, fq); S.done(cur); }
        if (!has_next) break;
#pragma unroll
        for (int a = 0; a < 2; ++a)
#pragma unroll
            for (int b = 0; b < 2; ++b)
#pragma unroll
                for (int m = 0; m < 4; ++m)
#pragma unroll
                    for (int n = 0; n < 2; ++n) acc[a][b][m][n] = (f32x4){0.f, 0.f, 0.f, 0.f};
        cur = nxt; cA = nA; cB = nB; ++ui;
#pragma unroll
        for (int h = 0; h < 2; ++h)
#pragma unroll
            for (int i = 0; i < 2; ++i) offC[h][i] = offN[h][i];
        if constexpr (ALIGN_EPI) { if (wr == 1) PG8_BAR; }
    }
    PG8_WAIT_V(0);
    if constexpr (!ALIGN_EPI) { if (wr == 0) PG8_BAR; }
    PG8_BAR;
    if constexpr (Epi::AFTER_DRAIN) { E.fused(acc, cur, wr, wc, fr, fq, lds, wid, lane); S.done(cur); }
#undef PG8_SA
#undef PG8_SB
#undef PG8_STAGE
#undef PG8_LDA
#undef PG8_LDB
#undef PG8_MMA
#undef PG8_WAIT_V
#undef PG8_WAIT_L
#undef PG8_BAR
#undef PG8_SCHED
}
}
#ifndef PG8_SP2
#define PG8_SP2 true
#endif
#ifndef PG8_ALIGN
#define PG8_ALIGN true
#endif
constexpr int NWAVES = 8;
constexpr int BATCH = 2, SEQ = 16384, T = BATCH * SEQ, D = 2048;
constexpr int NH = 8, HD = 128, GW = 1024, SCW = 1024;
constexpr int IN_COLS = 7184, NPROJ = 7168;
constexpr int NE = 64, DE = 512, CAP_ROWS = 65536 + 64 * 256, MAX_TILES = CAP_ROWS / 256;
constexpr float EPS = 1e-6f;
constexpr int N_PHASES = 11;
constexpr int NSCAN = 2 * BATCH * NH;
constexpr int GDN_SPLIT = 128;

constexpr size_t MiB = 1u << 20;
constexpr size_t WS_CTL = 0, CTL_ZERO_BYTES = 1 * MiB;
constexpr size_t WS_BA = 1 * MiB;
constexpr size_t WS_GB = 3 * MiB;
constexpr size_t WS_RSTD = 5 * MiB;
constexpr size_t WS_EID = 6 * MiB;
constexpr size_t WS_GATE = 7 * MiB;
constexpr size_t WS_POS = 8 * MiB;
constexpr size_t WS_ROWTOK = 9 * MiB;
constexpr size_t WS_ROWGATE = 10 * MiB;
constexpr size_t WS_TILES = 11 * MiB;
constexpr size_t WS_ROWSC = 11 * MiB + 512 * 1024;
constexpr size_t WS_DSC = 12 * MiB;
constexpr size_t WS_SBUF = 15 * MiB;
constexpr size_t WS_CNT = 13 * MiB;
constexpr size_t WS_WR = 14 * MiB;
constexpr size_t WS_SSQ = 940 * MiB;
constexpr size_t WS_WIN = 16 * MiB;
constexpr size_t WS_WOUT = 44 * MiB;
constexpr size_t WS_R0 = 52 * MiB;
constexpr size_t WS_R1 = 180 * MiB;
constexpr size_t WS_R3 = 628 * MiB;
constexpr size_t WS_H1B = 948 * MiB;
constexpr size_t WS_END = 1076 * MiB;
constexpr size_t GI_NW = 0, GI_QD = 16384, GI_AT = 32768, GI_KD = 40960, GI_DMA = 57344, GI_U = 57344, GI_UNIT = 73728;
constexpr size_t PROJ_T = (size_t)T * 1024;
constexpr size_t WGU_ELEMS = (size_t)NE * 1024 * 2048;

constexpr int RING_OFF = 0, RING_BYTES = 131072;
constexpr int LDS_BYTES = 151552;
constexpr int LDSCTL_OFF = LDS_BYTES - 256, MISC_OFF = LDSCTL_OFF;
constexpr int P2_KN = 0, P2_QN = 17408, P2_XT = 0  , P2_KT = 34816, P2_VT = 53248, P2_AM = 71680, P2_AT = 89088, P2_TU = 98304, P2_TW = 107520, P2_SM = 116736, P2_CW = 120832;
constexpr int P3_UB = 114688, P3_OB = 131072, P3_DL = 148480, P3_NW = 149504;
static_assert(P3_NW + 512 <= LDSCTL_OFF, "LDS map");

#define GAS __attribute__((address_space(1)))
#define LAS __attribute__((address_space(3)))
typedef unsigned short bf16;
typedef unsigned v4u __attribute__((ext_vector_type(4)));
typedef unsigned v2u __attribute__((ext_vector_type(2)));
typedef float f32x4 __attribute__((ext_vector_type(4)));
typedef GAS unsigned gu32;
typedef float f32x16 __attribute__((ext_vector_type(16)));
typedef short bf16x8 __attribute__((ext_vector_type(8)));
typedef __bf16 bf16x2_t __attribute__((ext_vector_type(2)));
typedef float f32x2_t __attribute__((ext_vector_type(2)));
__device__ __forceinline__ unsigned cvtpk(float lo, float hi) { f32x2_t v = {lo, hi}; bf16x2_t b = __builtin_convertvector(v, bf16x2_t); return __builtin_bit_cast(unsigned, b); }
#define pack8(X, s) __builtin_bit_cast(bf16x8, (v4u){cvtpk((X)[8 * (s)], (X)[8 * (s) + 1]), cvtpk((X)[8 * (s) + 2], (X)[8 * (s) + 3]), cvtpk((X)[8 * (s) + 4], (X)[8 * (s) + 5]), cvtpk((X)[8 * (s) + 6], (X)[8 * (s) + 7])})
#define RLX_AGENT __ATOMIC_RELAXED, __HIP_MEMORY_SCOPE_AGENT
#define LDS_WAIT() asm volatile("s_waitcnt lgkmcnt(0)" ::: "memory")
#define VM_WAIT() asm volatile("s_waitcnt vmcnt(0)" ::: "memory")
__device__ __forceinline__ unsigned f2bf(float f) { unsigned u = __builtin_bit_cast(unsigned, f); return (u + 0x7fffu + ((u >> 16) & 1u)) >> 16; }
__device__ __forceinline__ unsigned pk2(float lo, float hi) { return f2bf(lo) | (f2bf(hi) << 16); }
__device__ __forceinline__ float bflo(unsigned u) { return __builtin_bit_cast(float, u << 16); }
__device__ __forceinline__ float bfhi(unsigned u) { return __builtin_bit_cast(float, u & 0xffff0000u); }
__device__ __forceinline__ float wave_sum(float v) {
#pragma unroll
    for (int o = 1; o < 64; o <<= 1) v += __shfl_xor(v, o);
    return v;
}
__device__ __forceinline__ float siluf(float x) { return x * __builtin_amdgcn_rcpf(1.0f + __expf(-x)); }

#define XB_TMO      128
#define XB_XCNT(j)  (256  + 64 * (j))
#define XB_XSUB(j)  (1280 + 64 * (j))
#define XB_XGEN(j)  (2304 + 64 * (j))
#define XB_TOP      3328
#define XB_TOPGEN   3392
#define XCD_BAR_WORDS 3456
#define XB_SPIN_CAP (1u << 18)
__device__ __forceinline__ unsigned xb_ld(unsigned* p)              { return __hip_atomic_load(p, __ATOMIC_RELAXED, __HIP_MEMORY_SCOPE_AGENT); }
__device__ __forceinline__ unsigned xb_add(unsigned* p, unsigned v) { return __hip_atomic_fetch_add(p, v, __ATOMIC_RELAXED, __HIP_MEMORY_SCOPE_AGENT); }
__device__ __forceinline__ unsigned xb_xcc_id() { return (unsigned)__builtin_amdgcn_s_getreg((3 << 11) | 20) & 0xFu; }
#define XB_SPIN(cond, bar) do { unsigned _sp = 0; while (cond) { __builtin_amdgcn_s_sleep(1); \
    if ((++_sp & 255u) == 0u) { if (xb_ld(&(bar)[XB_TMO])) break; if (_sp > XB_SPIN_CAP) { atomicAdd(&(bar)[XB_TMO], 1u); break; } } } } while (0)
struct XcdBarrier { unsigned* bar; unsigned x; volatile LAS unsigned* st; int wv; };
#define XB_T0(wv) ((wv) == 0 && lane_id_v() == 0)
__device__ __forceinline__ XcdBarrier xcd_barrier_post(unsigned* bar, volatile LAS unsigned* st, int wv) {
    XcdBarrier b; b.bar = bar; b.x = xb_xcc_id(); b.st = st; b.wv = wv;
    if (XB_T0(wv)) (void)xb_add(&bar[XB_XCNT(b.x)], 1u);
    return b;
}
__device__ __forceinline__ void xcd_barrier_complete(unsigned* bar, unsigned x, unsigned& nloc, unsigned& nx) {
    const unsigned G = gridDim.x * gridDim.y * gridDim.z;
    unsigned sum, cnt, mine, sp = 0u;
    for (;;) {
        sum = 0u; cnt = 0u; mine = 0u;
#pragma unroll
        for (unsigned j = 0; j < 16; ++j) { const unsigned c = xb_ld(&bar[XB_XCNT(j)]); sum += c; cnt += (c > 0u) ? 1u : 0u; mine = (j == x) ? c : mine; }
        if (sum == G) break;
        __builtin_amdgcn_s_sleep(1);
        if ((++sp & 255u) == 0u) { if (xb_ld(&bar[XB_TMO])) break; if (sp > XB_SPIN_CAP) { atomicAdd(&bar[XB_TMO], 1u); break; } }
    }
    nloc = mine > 0u ? mine : 1u; nx = cnt > 0u ? cnt : 1u;
}
__device__ __forceinline__ void xcd_barrier(const XcdBarrier& b) {
    asm volatile("s_waitcnt vmcnt(0)" ::: "memory");
    __syncthreads();
    if (XB_T0(b.wv)) {
        unsigned* bar = b.bar;
        __builtin_amdgcn_s_waitcnt(0);
        unsigned nloc = b.st[0], nx = b.st[1];
        if (nloc == 0u) { xcd_barrier_complete(bar, b.x, nloc, nx); b.st[0] = nloc; b.st[1] = nx; }
        const unsigned old = xb_add(&bar[XB_XSUB(b.x)], 1u);
        const unsigned gen = old / nloc;
        if (old + 1u == (gen + 1u) * nloc) {
            __builtin_amdgcn_fence(__ATOMIC_RELEASE, "agent");
            asm volatile("s_waitcnt vmcnt(0)" ::: "memory");
            const unsigned og = xb_add(&bar[XB_TOP], 1u);
            const unsigned tg = og / nx;
            if (og + 1u == (tg + 1u) * nx) xb_add(&bar[XB_TOPGEN], 1u);
            else XB_SPIN(xb_ld(&bar[XB_TOPGEN]) == tg, bar);
            __builtin_amdgcn_fence(__ATOMIC_ACQUIRE, "agent");
            xb_add(&bar[XB_XGEN(b.x)], 1u);
            asm volatile("s_waitcnt vmcnt(0)" ::: "memory");
        } else {
            XB_SPIN(xb_ld(&bar[XB_XGEN(b.x)]) == gen, bar);
            __builtin_amdgcn_fence(__ATOMIC_ACQUIRE, "agent");
            asm volatile("s_waitcnt vmcnt(0)" ::: "memory");
        }
    }
    __syncthreads();
}

__device__ __forceinline__ void transpose_item(const float* W, int ldw, int scol0, int k0, bf16* WT, int K, int drow0, LAS float* scr, int lane, const float* kscale) {
    f32x4 v[16];
    f32x4 s0 = (f32x4){1.f, 1.f, 1.f, 1.f}, s1 = s0;
    if (kscale) { s0 = *(const f32x4*)(kscale + k0 + 8 * (lane & 7)); s1 = *(const f32x4*)(kscale + k0 + 8 * (lane & 7) + 4); }
    const float* src = W + (size_t)(k0 + (lane >> 4)) * ldw + scol0 + 4 * (lane & 15);
#pragma unroll
    for (int i = 0; i < 16; ++i) v[i] = *(const f32x4*)(src + (size_t)(4 * i) * ldw);
#pragma unroll
    for (int i = 0; i < 16; ++i) { LAS float* d = scr + (4 * i + (lane >> 4)) * 65 + 4 * (lane & 15); d[0] = v[i].x; d[1] = v[i].y; d[2] = v[i].z; d[3] = v[i].w; }
    LDS_WAIT(); asm volatile("" ::: "memory");
#pragma unroll
    for (int q = 0; q < 8; ++q) { const int t = lane + 64 * q, n = t >> 3, c8 = t & 7; const LAS float* sp = scr + (8 * c8) * 65 + n;
        float e[8];
#pragma unroll
        for (int j = 0; j < 8; ++j) e[j] = sp[j * 65];
        v4u o; o.x = cvtpk(e[0] * s0.x, e[1] * s0.y); o.y = cvtpk(e[2] * s0.z, e[3] * s0.w); o.z = cvtpk(e[4] * s1.x, e[5] * s1.y); o.w = cvtpk(e[6] * s1.z, e[7] * s1.w);
        *(GAS v4u*)(WT + (size_t)(drow0 + n) * K + k0 + 8 * c8) = o; }
    LDS_WAIT(); asm volatile("" ::: "memory");
}

__device__ __forceinline__ void gdn_prep(LAS unsigned char* lds, const int wave, const int wgi, const int nwg, const int clo, const int chi,
                                         const bf16* PROJ, const float* conv_qkv_w, const float* BA, const float* a_log, const float* dt_bias, unsigned char* GI, float* DSC) {
        LAS bf16* KNt = (LAS bf16*)(lds + P2_KN); LAS bf16* QNt = (LAS bf16*)(lds + P2_QN); LAS bf16* KTt = (LAS bf16*)(lds + P2_KT); LAS bf16* VTt = (LAS bf16*)(lds + P2_VT);
        LAS float* AMt = (LAS float*)(lds + P2_AM); LAS bf16* ATt = (LAS bf16*)(lds + P2_AT); LAS float* SMt = (LAS float*)(lds + P2_SM); LAS bf16* XTt = (LAS bf16*)(lds + P2_XT);
        LAS bf16* TUt = (LAS bf16*)(lds + P2_TU); LAS bf16* TWt = (LAS bf16*)(lds + P2_TW);
        v4u raw[3][4][2];
#define P2_RAWLOAD(qi_) do { const int ch_ = chi - 1 - (qi_) / (BATCH * NH), bh_ = (qi_) % (BATCH * NH); const int l_ = lane_id_v(), t_ = wave * 64 + l_, row_ = t_ >> 3, c0_ = (t_ & 7) * 16; \
            const int tt_ = ch_ * 64 + row_; const size_t tok_ = (size_t)(bh_ / NH) * SEQ + tt_; \
            _Pragma("unroll") for (int ten = 0; ten < 3; ++ten) { const bf16* src_ = PROJ + (size_t)ten * PROJ_T + tok_ * 1024 + (bh_ % NH) * 128 + c0_; \
                _Pragma("unroll") for (int j = 0; j < 4; ++j) { \
                    if (tt_ - 3 + j >= 0) { const v4u* p_ = (const v4u*)(src_ + (ptrdiff_t)(j - 3) * 1024); raw[ten][j][0] = p_[0]; raw[ten][j][1] = p_[1]; } \
                    else { raw[ten][j][0] = (v4u){0u, 0u, 0u, 0u}; raw[ten][j][1] = (v4u){0u, 0u, 0u, 0u}; } } } } while (0)
        if (wgi < (chi - clo) * BATCH * NH) P2_RAWLOAD(wgi);
        LAS float* CWt = (LAS float*)(lds + P2_CW); int cw_h = -1;
        for (int qi = wgi; qi < (chi - clo) * BATCH * NH; qi += nwg) {
            const int un_ch = chi - 1 - qi / (BATCH * NH), un_bh = qi % (BATCH * NH);
            const int laneu = lane_id_v(), tidu = wave * 64 + laneu;
            const int b = un_bh / NH, ch = un_ch, h = un_bh % NH, t0 = b * SEQ + ch * 64;
            const int uid = (b * NH + h) * (SEQ / 64) + ch;
            unsigned char* ub = (unsigned char*)GI + (size_t)uid * GI_UNIT;
            if (h != cw_h) {
                asm volatile("s_waitcnt lgkmcnt(0)" ::: "memory"); __builtin_amdgcn_s_barrier(); asm volatile("" ::: "memory");
#pragma unroll
                for (int i = 0; i < 3; ++i) { const int idx = tidu + NWAVES * 64 * i, ten = idx >> 9, j = (idx >> 7) & 3, c = idx & 127; CWt[idx] = conv_qkv_w[(size_t)j * 3072 + ten * 1024 + h * 128 + c]; }
                asm volatile("s_waitcnt lgkmcnt(0)" ::: "memory"); __builtin_amdgcn_s_barrier(); asm volatile("" ::: "memory");
                cw_h = h; }
            {
                const int row = tidu >> 3, c0 = (tidu & 7) * 16, tt = ch * 64 + row;
                float bl = 0.f, al = 0.f;
                if (wave == 0) { bl = BA[(size_t)(t0 + laneu) * 16 + h]; al = BA[(size_t)(t0 + laneu) * 16 + 8 + h]; }
#pragma unroll
                for (int ten = 0; ten < 3; ++ten) {
                    float acc[16];
#pragma unroll
                    for (int i = 0; i < 16; ++i) acc[i] = 0.f;
#pragma unroll
                    for (int j = 0; j < 4; ++j) {
                        {
                            const v4u a = raw[ten][j][0], bb = raw[ten][j][1];
                            const LAS f32x4* wp = (const LAS f32x4*)(CWt + (ten * 4 + j) * 128 + c0); const f32x4 w0 = wp[0], w1 = wp[1], w2 = wp[2], w3 = wp[3];
                            acc[0] += bflo(a.x) * w0.x; acc[1] += bfhi(a.x) * w0.y; acc[2] += bflo(a.y) * w0.z; acc[3] += bfhi(a.y) * w0.w;
                            acc[4] += bflo(a.z) * w1.x; acc[5] += bfhi(a.z) * w1.y; acc[6] += bflo(a.w) * w1.z; acc[7] += bfhi(a.w) * w1.w;
                            acc[8] += bflo(bb.x) * w2.x; acc[9] += bfhi(bb.x) * w2.y; acc[10] += bflo(bb.y) * w2.z; acc[11] += bfhi(bb.y) * w2.w;
                            acc[12] += bflo(bb.z) * w3.x; acc[13] += bfhi(bb.z) * w3.y; acc[14] += bflo(bb.w) * w3.z; acc[15] += bfhi(bb.w) * w3.w;
                        }
                    }
                    float ss = 0.f;
#pragma unroll
                    for (int i = 0; i < 16; ++i) { acc[i] = siluf(acc[i]); ss += acc[i] * acc[i]; }
                    ss += __shfl_xor(ss, 1); ss += __shfl_xor(ss, 2); ss += __shfl_xor(ss, 4);
                    const float sc = (ten == 0) ? rsqrtf(ss + EPS) * 0.08838834764831845f : (ten == 1 ? rsqrtf(ss + EPS) : 1.f);
                    unsigned pw[8];
#pragma unroll
                    for (int i = 0; i < 8; ++i) pw[i] = cvtpk(acc[2 * i] * sc, acc[2 * i + 1] * sc);
                    if (ten < 2) { v4u o0, o1; o0.x = pw[0]; o0.y = pw[1]; o0.z = pw[2]; o0.w = pw[3]; o1.x = pw[4]; o1.y = pw[5]; o1.z = pw[6]; o1.w = pw[7];
                        LAS v4u* dst = (LAS v4u*)((ten == 0 ? QNt : KNt) + row * 136 + c0); dst[0] = o0; dst[1] = o1; }
                    if (ten >= 1) { LAS bf16* tp = (ten == 1 ? KTt : VTt) + c0 * 72 + row;
#pragma unroll
                        for (int i = 0; i < 8; ++i) { tp[(2 * i) * 72] = (bf16)pw[i]; tp[(2 * i + 1) * 72] = (bf16)(pw[i] >> 16); } }
                }
                if (wave == 0) {
                    const float xs = al + dt_bias[h]; const float sp = xs > 20.f ? xs : __logf(1.0f + __expf(xs));
                    float gcv = -__expf(a_log[h]) * sp;
#pragma unroll
                    for (int o = 1; o < 64; o <<= 1) { const float v = __shfl_up(gcv, o); if (laneu >= o) gcv += v; }
                    const float gl = __shfl(gcv, 63);
                    SMt[laneu] = gcv; SMt[64 + laneu] = __expf(gcv); SMt[128 + laneu] = __expf(gl - gcv); SMt[192 + laneu] = __builtin_amdgcn_rcpf(1.0f + __expf(-bl));
                    if (laneu == 0) DSC[uid] = __expf(gl);
                }
            }
            asm volatile("s_waitcnt lgkmcnt(0)" ::: "memory"); __builtin_amdgcn_s_barrier(); asm volatile("" ::: "memory");
            {
                const int mat = wave >> 2, mb = wave & 3, fr = laneu & 15, fg = laneu >> 4;
                const LAS bf16* Am = mat ? QNt : KNt;
                pg8::bf16x8 af[4], bfr[4][4];
#pragma unroll
                for (int ks = 0; ks < 4; ++ks) af[ks] = *(const LAS pg8::bf16x8*)(Am + (16 * mb + fr) * 136 + 32 * ks + 8 * fg);
#pragma unroll
                for (int nb = 0; nb < 4; ++nb)
#pragma unroll
                    for (int ks = 0; ks < 4; ++ks) bfr[nb][ks] = *(const LAS pg8::bf16x8*)(KNt + (16 * nb + fr) * 136 + 32 * ks + 8 * fg);
                float gi[4], bi[4], gj[4];
#pragma unroll
                for (int r = 0; r < 4; ++r) { gi[r] = SMt[16 * mb + 4 * fg + r]; bi[r] = SMt[192 + 16 * mb + 4 * fg + r]; gj[r] = SMt[16 * r + fr]; }
                pg8::f32x4 acc[4];
#pragma unroll
                for (int nb = 0; nb < 4; ++nb) acc[nb] = (pg8::f32x4){0.f, 0.f, 0.f, 0.f};
#pragma unroll
                for (int ks = 0; ks < 4; ++ks)
#pragma unroll
                    for (int nb = 0; nb < 4; ++nb) acc[nb] = __builtin_amdgcn_mfma_f32_16x16x32_bf16(af[ks], bfr[nb][ks], acc[nb], 0, 0, 0);
#pragma unroll
                for (int nb = 0; nb < 4; ++nb) {
                    const int j = 16 * nb + fr; f32x4 av; unsigned short tv[4];
#pragma unroll
                    for (int r = 0; r < 4; ++r) {
                        const int i = 16 * mb + 4 * fg + r;
                        const float dec = (i >= j) ? __expf(gi[r] - gj[nb]) : 0.f;
                        av[r] = (i > j) ? bi[r] * acc[nb][r] * dec : 0.f;
                        tv[r] = (unsigned short)f2bf(acc[nb][r] * dec);
                    }
                    if (mat == 0) *(LAS f32x4*)(AMt + j * 68 + 16 * mb + 4 * fg) = av;
                    else {
#pragma unroll
                        for (int r = 0; r < 4; ++r) ATt[(16 * mb + 4 * fg + r) * 72 + j] = (bf16)tv[r]; }
                }
            }
            asm volatile("s_waitcnt lgkmcnt(0)" ::: "memory"); __builtin_amdgcn_s_barrier(); asm volatile("" ::: "memory");
            if (wave == 0) {
                const int c = laneu; f32x4 xq[16];
#pragma unroll
                for (int i = 0; i < 64; ++i) xq[i >> 2][i & 3] = (i == c) ? 1.f : 0.f;
                const LAS float* AMb = AMt; asm volatile("" : "+v"(AMb));
#pragma unroll
                for (int bq = 0; bq < 16; ++bq) {
                    const f32x4 d0 = *(const LAS f32x4*)(AMb + (4 * bq) * 68 + 4 * bq), d1 = *(const LAS f32x4*)(AMb + (4 * bq + 1) * 68 + 4 * bq), d2 = *(const LAS f32x4*)(AMb + (4 * bq + 2) * 68 + 4 * bq);
                    const float x0 = xq[bq].x;
                    const float x1 = xq[bq].y - d0.y * x0;
                    const float x2 = (xq[bq].z - d0.z * x0) - d1.z * x1;
                    const float x3 = ((xq[bq].w - d0.w * x0) - d1.w * x1) - d2.w * x2;
                    xq[bq] = (f32x4){x0, x1, x2, x3};
#pragma unroll
                    for (int q = bq + 1; q < 16; ++q) {
                        const f32x4 r0 = *(const LAS f32x4*)(AMb + (4 * bq) * 68 + 4 * q), r1 = *(const LAS f32x4*)(AMb + (4 * bq + 1) * 68 + 4 * q), r2 = *(const LAS f32x4*)(AMb + (4 * bq + 2) * 68 + 4 * q), r3 = *(const LAS f32x4*)(AMb + (4 * bq + 3) * 68 + 4 * q);
                        xq[q] -= (r0 * x0 + r1 * x1) + (r2 * x2 + r3 * x3);
                    }
                }
                const float su = SMt[192 + c], sw = -SMt[192 + c] * SMt[64 + c];
#pragma unroll
                for (int i = 0; i < 64; i += 2) { const unsigned pu = cvtpk(xq[i >> 2][i & 3] * su, xq[(i + 1) >> 2][(i + 1) & 3] * su), pw2 = cvtpk(xq[i >> 2][i & 3] * sw, xq[(i + 1) >> 2][(i + 1) & 3] * sw);
                    TUt[i * 72 + c] = (bf16)pu; TUt[(i + 1) * 72 + c] = (bf16)(pu >> 16); TWt[i * 72 + c] = (bf16)pw2; TWt[(i + 1) * 72 + c] = (bf16)(pw2 >> 16); }
            } else if (wave < 4) {
            } else {
                const int t2 = tidu - 256;
#pragma unroll 1
                for (int q = 0; q < 4; ++q) {
                    const int p = t2 + 256 * q, blk = p >> 6, l = p & 63, r = l & 31, hh = l >> 5, mb = blk >> 3, ks = blk & 7, i = 32 * mb + r;
                    const v2u lo = *(const LAS v2u*)(QNt + i * 136 + 16 * ks + 4 * hh), hi2 = *(const LAS v2u*)(QNt + i * 136 + 16 * ks + 8 + 4 * hh); const float e = SMt[64 + i];
                    v4u o; o.x = pk2(bflo(lo.x) * e, bfhi(lo.x) * e); o.y = pk2(bflo(lo.y) * e, bfhi(lo.y) * e); o.z = pk2(bflo(hi2.x) * e, bfhi(hi2.x) * e); o.w = pk2(bflo(hi2.y) * e, bfhi(hi2.y) * e);
                    *(v4u*)(ub + GI_QD + (size_t)p * 16) = o;
                }
#pragma unroll 1
                for (int q = 0; q < 4; ++q) {
                    const int p = t2 + 256 * q, blk = p >> 6, l = p & 63, r = l & 31, hh = l >> 5, mb = blk >> 2, ks = blk & 3, d = 32 * mb + r;
                    float v[8];
#pragma unroll
                    for (int j = 0; j < 8; ++j) { const int ip = 16 * ks + 8 * (j >> 2) + 4 * hh + (j & 3); v[j] = bflo(KNt[ip * 136 + d]) * SMt[128 + ip]; }
                    v4u o; o.x = pk2(v[0], v[1]); o.y = pk2(v[2], v[3]); o.z = pk2(v[4], v[5]); o.w = pk2(v[6], v[7]);
                    *(v4u*)(ub + GI_KD + (size_t)p * 16) = o;
                }
#pragma unroll 1
                for (int q = 0; q < 2; ++q) {
                    const int p = t2 + 256 * q, blk = p >> 6, l = p & 63, r = l & 31, hh = l >> 5, mb = blk >> 2, ks = blk & 3, i = 32 * mb + r;
                    const v2u lo = *(const LAS v2u*)(ATt + i * 72 + 16 * ks + 4 * hh), hi2 = *(const LAS v2u*)(ATt + i * 72 + 16 * ks + 8 + 4 * hh);
                    v4u o; o.x = lo.x; o.y = lo.y; o.z = hi2.x; o.w = hi2.y;
                    *(v4u*)(ub + GI_AT + (size_t)p * 16) = o;
                }
            }
            asm volatile("s_waitcnt lgkmcnt(0)" ::: "memory"); __builtin_amdgcn_s_barrier(); asm volatile("" ::: "memory");
            if (qi + nwg < (chi - clo) * BATCH * NH) P2_RAWLOAD(qi + nwg);
            {
                const int mat = wave >> 2, mb = wave & 3, fr = laneu & 15, fg = laneu >> 4;
                const LAS bf16* Tm = mat ? TWt : TUt; const LAS bf16* Bm = mat ? KTt : VTt;
                const pg8::bf16x8 a0 = *(const LAS pg8::bf16x8*)(Tm + (16 * mb + fr) * 72 + 8 * fg), a1 = *(const LAS pg8::bf16x8*)(Tm + (16 * mb + fr) * 72 + 32 + 8 * fg);
                pg8::bf16x8 b0[8], b1[8];
#pragma unroll
                for (int nb = 0; nb < 8; ++nb) { b0[nb] = *(const LAS pg8::bf16x8*)(Bm + (16 * nb + fr) * 72 + 8 * fg); b1[nb] = *(const LAS pg8::bf16x8*)(Bm + (16 * nb + fr) * 72 + 32 + 8 * fg); }
                pg8::f32x4 acc[8];
#pragma unroll
                for (int nb = 0; nb < 8; ++nb) acc[nb] = __builtin_amdgcn_mfma_f32_16x16x32_bf16(a0, b0[nb], (pg8::f32x4){0.f, 0.f, 0.f, 0.f}, 0, 0, 0);
#pragma unroll
                for (int nb = 0; nb < 8; ++nb) acc[nb] = __builtin_amdgcn_mfma_f32_16x16x32_bf16(a1, b1[nb], acc[nb], 0, 0, 0);
#pragma unroll
                for (int nb = 0; nb < 8; ++nb) {
                    const unsigned p01 = cvtpk(acc[nb][0], acc[nb][1]), p23 = cvtpk(acc[nb][2], acc[nb][3]); LAS bf16* xp = XTt + (16 * mb + 4 * fg) * 264 + mat * 128 + 16 * nb + fr;
                    xp[0] = (bf16)p01; xp[264] = (bf16)(p01 >> 16); xp[528] = (bf16)p23; xp[792] = (bf16)(p23 >> 16);
                }
            }
            asm volatile("s_waitcnt lgkmcnt(0)" ::: "memory"); __builtin_amdgcn_s_barrier(); asm volatile("" ::: "memory");
            {
#pragma unroll 1
                for (int q = 0; q < 2; ++q) {
                    const int p = tidu + 512 * q, blk = p >> 6, l = p & 63, r = l & 31, hh = l >> 5, mb = blk >> 3, ks = blk & 7, i = 32 * mb + r;
                    const v2u lo = *(const LAS v2u*)(XTt + i * 264 + 128 + 16 * ks + 4 * hh), hi2 = *(const LAS v2u*)(XTt + i * 264 + 128 + 16 * ks + 8 + 4 * hh);
                    v4u o; o.x = lo.x; o.y = lo.y; o.z = hi2.x; o.w = hi2.y;
                    *(v4u*)(ub + GI_NW + (size_t)p * 16) = o;
                }
                {
                    const int p = tidu, blk = p >> 6, l = p & 63, r = l & 31, hh = l >> 5, nq = blk >> 1, mb = blk & 1, col = 32 * nq + r;
                    unsigned w[8];
#pragma unroll
                    for (int rg = 0; rg < 16; rg += 2) { const int i0 = 32 * mb + (rg & 3) + 8 * (rg >> 2) + 4 * hh; w[rg >> 1] = (unsigned)XTt[i0 * 264 + col] | ((unsigned)XTt[(i0 + 1) * 264 + col] << 16); }
                    v4u o0, o1; o0.x = w[0]; o0.y = w[1]; o0.z = w[2]; o0.w = w[3]; o1.x = w[4]; o1.y = w[5]; o1.z = w[6]; o1.w = w[7];
                    v4u* dst = (v4u*)(ub + GI_U + (size_t)p * 32); dst[0] = o0; dst[1] = o1;
                }
            }
            asm volatile("s_waitcnt lgkmcnt(0)" ::: "memory"); __builtin_amdgcn_s_barrier(); asm volatile("" ::: "memory");
        }
}

#undef P2_RAWLOAD
__device__ __forceinline__ void gdn_scan(LAS unsigned char* lds, const int wave, const int bh, const int half, const int c0, const int c1,
                                         const unsigned char* GI, const float* DSC, bf16* Y, float* SBUF) {
        {
            const int b = bh / NH, h = bh % NH; const int lane = lane_id_v(), tid = wave * 64 + lane;
            const unsigned char* gbase = (const unsigned char*)GI + (size_t)bh * (SEQ / 64) * GI_UNIT;
            LAS unsigned short* OB = (LAS unsigned short*)(lds + P3_OB);
            LAS unsigned char* UB = lds + P3_UB;
            LAS float* DL = (LAS float*)(lds + P3_DL);
            constexpr int NCH = SEQ / 64;
            if (tid < NCH) DL[tid] = DSC[bh * NCH + tid];
            if (wave == 2 || wave == 3) {
                asm volatile("s_waitcnt lgkmcnt(0)" ::: "memory"); __builtin_amdgcn_s_barrier();
                for (int c = c0; c < c1; ++c) { __builtin_amdgcn_s_barrier(); __builtin_amdgcn_s_barrier(); }
            } else if (wave < 2) {
                __builtin_amdgcn_s_setprio(3);
                const int nq = half * 2 + wave, r = lane & 31, hh = lane >> 5;
                f32x16 S[4], O[2];
#pragma unroll
                for (int i = 0; i < 16; ++i) { S[0][i] = 0.f; S[1][i] = 0.f; S[2][i] = 0.f; S[3][i] = 0.f; O[0][i] = 0.f; O[1][i] = 0.f; }
                float* sbp = SBUF + ((size_t)(bh * 4 + nq) * 64 + lane) * 64;
                if (c0 > 0) {
#pragma unroll
                    for (int t = 0; t < 4; ++t)
#pragma unroll
                        for (int q = 0; q < 4; ++q) { const f32x4 v = *(const f32x4*)(sbp + t * 16 + q * 4); S[t][4 * q] = v.x; S[t][4 * q + 1] = v.y; S[t][4 * q + 2] = v.z; S[t][4 * q + 3] = v.w; }
                }
#define P3_FOFF(i) ((i) < 32 ? ((((i) & 3) < 2 ? (int)GI_NW : (int)GI_QD) + ((((i) & 1) * 8 + ((i) >> 2)) * 64) * 16) \
                             : ((((i) - 32) % 6) < 2 ? (int)GI_AT + (((((i) - 32) % 6) * 4 + ((i) - 32) / 6) * 64) * 16 : (int)GI_KD + ((((((i) - 32) % 6) - 2) * 4 + ((i) - 32) / 6) * 64) * 16))
                constexpr int PD = 6;
                asm volatile("s_waitcnt lgkmcnt(0)" ::: "memory"); __builtin_amdgcn_s_barrier(); asm volatile("" ::: "memory");
                for (int c = c0; c < c1; ++c) {
                    const LAS unsigned char* ab = lds + (c & 1) * GI_DMA + lane * 16;
                    bf16x8 R[PD];
#pragma unroll
                    for (int i = 0; i < PD; ++i) R[i] = *(const LAS bf16x8*)(ab + P3_FOFF(i));
                    const float dcur = DL[c];
                    f32x16 V[2];
                    { const v4u ua = *(const LAS v4u*)(UB + ((nq * 2) * 64 + lane) * 32), ub2 = *(const LAS v4u*)(UB + ((nq * 2) * 64 + lane) * 32 + 16);
                      const v4u uc = *(const LAS v4u*)(UB + ((nq * 2 + 1) * 64 + lane) * 32), ud = *(const LAS v4u*)(UB + ((nq * 2 + 1) * 64 + lane) * 32 + 16);
                      V[0][0] = bflo(ua.x); V[0][1] = bfhi(ua.x); V[0][2] = bflo(ua.y); V[0][3] = bfhi(ua.y); V[0][4] = bflo(ua.z); V[0][5] = bfhi(ua.z); V[0][6] = bflo(ua.w); V[0][7] = bfhi(ua.w);
                      V[0][8] = bflo(ub2.x); V[0][9] = bfhi(ub2.x); V[0][10] = bflo(ub2.y); V[0][11] = bfhi(ub2.y); V[0][12] = bflo(ub2.z); V[0][13] = bfhi(ub2.z); V[0][14] = bflo(ub2.w); V[0][15] = bfhi(ub2.w);
                      V[1][0] = bflo(uc.x); V[1][1] = bfhi(uc.x); V[1][2] = bflo(uc.y); V[1][3] = bfhi(uc.y); V[1][4] = bflo(uc.z); V[1][5] = bfhi(uc.z); V[1][6] = bflo(uc.w); V[1][7] = bfhi(uc.w);
                      V[1][8] = bflo(ud.x); V[1][9] = bfhi(ud.x); V[1][10] = bflo(ud.y); V[1][11] = bfhi(ud.y); V[1][12] = bflo(ud.z); V[1][13] = bfhi(ud.z); V[1][14] = bflo(ud.w); V[1][15] = bfhi(ud.w); }
                    bf16x8 Sb[8], Vb[4];
                    Sb[0] = pack8(S[0], 0); Sb[1] = pack8(S[0], 1); Sb[2] = pack8(S[1], 0); Sb[3] = pack8(S[1], 1); Sb[4] = pack8(S[2], 0); Sb[5] = pack8(S[2], 1); Sb[6] = pack8(S[3], 0); Sb[7] = pack8(S[3], 1);
#pragma unroll
                    for (int i = 0; i < 16; ++i) { O[0][i] = 0.f; O[1][i] = 0.f; }
                    __builtin_amdgcn_sched_barrier(0);
#define P3_STEP(i) { const bf16x8 f_ = R[(i) % PD]; \
                        if ((i) < 32) { if (((i) & 3) < 2) V[(i) & 1] = __builtin_amdgcn_mfma_f32_32x32x16_bf16(f_, Sb[((i) >> 2) & 7], V[(i) & 1], 0, 0, 0); else O[(i) & 1] = __builtin_amdgcn_mfma_f32_32x32x16_bf16(f_, Sb[((i) >> 2) & 7], O[(i) & 1], 0, 0, 0); } \
                        else { if ((((i) - 32) % 6) < 2) O[(((i) - 32) % 6) & 1] = __builtin_amdgcn_mfma_f32_32x32x16_bf16(f_, Vb[(((i) - 32) / 6) & 3], O[(((i) - 32) % 6) & 1], 0, 0, 0); \
                               else S[((((i) - 32) % 6) - 2) & 3] = __builtin_amdgcn_mfma_f32_32x32x16_bf16(f_, Vb[(((i) - 32) / 6) & 3], S[((((i) - 32) % 6) - 2) & 3], 0, 0, 0); } \
                        if ((i) + PD < 56) R[(i) % PD] = *(const LAS bf16x8*)(ab + P3_FOFF(((i) + PD) % 56)); \
                        __builtin_amdgcn_sched_barrier(0); }
#define P3_STEP8(b) P3_STEP((b)) P3_STEP((b) + 1) P3_STEP((b) + 2) P3_STEP((b) + 3) P3_STEP((b) + 4) P3_STEP((b) + 5) P3_STEP((b) + 6) P3_STEP((b) + 7)
                    P3_STEP8(0) P3_STEP8(8) P3_STEP8(16) P3_STEP8(24)
                    Vb[0] = pack8(V[0], 0); Vb[1] = pack8(V[0], 1); Vb[2] = pack8(V[1], 0); Vb[3] = pack8(V[1], 1);
#pragma unroll
                    for (int q = 0; q < 16; ++q) { S[0][q] *= dcur; S[1][q] *= dcur; S[2][q] *= dcur; S[3][q] *= dcur; }
                    __builtin_amdgcn_sched_barrier(0);
                    P3_STEP8(32) P3_STEP8(40) P3_STEP8(48)
#undef P3_STEP8
#undef P3_STEP
                    asm volatile("s_waitcnt lgkmcnt(0)" ::: "memory"); __builtin_amdgcn_s_barrier(); asm volatile("" ::: "memory");
#pragma unroll
                    for (int rg = 0; rg < 16; ++rg) { const int row = (rg & 3) + 8 * (rg >> 2) + 4 * hh; const unsigned pk_ = cvtpk(O[0][rg], O[1][rg]); OB[row * 136 + 32 * nq + r] = (unsigned short)pk_; OB[(32 + row) * 136 + 32 * nq + r] = (unsigned short)(pk_ >> 16); }
                    asm volatile("s_waitcnt lgkmcnt(0)" ::: "memory"); __builtin_amdgcn_s_barrier(); asm volatile("" ::: "memory");
                }
#undef P3_FOFF
                if (c1 < NCH) {
#pragma unroll
                    for (int t = 0; t < 4; ++t)
#pragma unroll
                        for (int q = 0; q < 4; ++q) *(f32x4*)(sbp + t * 16 + q * 4) = (f32x4){S[t][4 * q], S[t][4 * q + 1], S[t][4 * q + 2], S[t][4 * q + 3]};
                }
                __builtin_amdgcn_s_setprio(0);
            } else {
                const int lw = wave - 4, lt = tid - 256;
                const __amdgpu_buffer_rsrc_t grsrc = __builtin_amdgcn_make_buffer_rsrc((void*)gbase, 0, (int)((SEQ / 64) * GI_UNIT), 0x00020000);
                v4u ra[14], ru_a[2], rb[14], ru_b[2];
#define P3_LOAD(rs, ru, ch) do { const int so_ = (ch) * (int)GI_UNIT; \
        _Pragma("unroll") for (int k_ = 0; k_ < 14; ++k_) rs[k_] = __builtin_amdgcn_raw_buffer_load_b128(grsrc, lt * 16, so_ + k_ * 4096, 0); \
        _Pragma("unroll") for (int k_ = 0; k_ < 2; ++k_) ru[k_] = __builtin_amdgcn_raw_buffer_load_b128(grsrc, lt * 16, so_ + (int)GI_U + half * 8192 + k_ * 4096, 0); } while (0)
#define P3_PUT(rs, bufi) do { LAS unsigned char* db_ = lds + (bufi) * GI_DMA; _Pragma("unroll") for (int k_ = 0; k_ < 14; ++k_) *(LAS v4u*)(db_ + (k_ * 256 + lt) * 16) = rs[k_]; } while (0)
#define P3_PUTU(ru) do { _Pragma("unroll") for (int k_ = 0; k_ < 2; ++k_) *(LAS v4u*)(UB + half * 8192 + (k_ * 256 + lt) * 16) = ru[k_]; } while (0)
#define P3_OCOPY(cprev) do { const int tb_ = b * SEQ + (cprev) * 64, row_ = lw * 16 + (lane >> 2), sg_ = lane & 3; \
        _Pragma("unroll") for (int q_ = 0; q_ < 2; ++q_) { const v4u ov_ = *(const LAS v4u*)(OB + row_ * 136 + half * 64 + sg_ * 16 + q_ * 8); \
            *(v4u*)(Y + (size_t)(tb_ + row_) * D + h * 128 + half * 64 + sg_ * 16 + q_ * 8) = ov_; } } while (0)
#define P3_BAR() do { asm volatile("s_waitcnt lgkmcnt(0)" ::: "memory"); __builtin_amdgcn_s_barrier(); asm volatile("" ::: "memory"); } while (0)
                P3_LOAD(ra, ru_a, c0); P3_LOAD(rb, ru_b, c0 + 1);
                P3_PUT(ra, 0); P3_PUTU(ru_a);
                P3_LOAD(ra, ru_a, c0 + 2);
                P3_BAR();
                for (int c = c0; c < c1; c += 2) {
                    if (c + 1 < c1) P3_PUT(rb, 1);
                    if (c > c0) { P3_OCOPY(c - 1); }
                    P3_BAR();
                    if (c + 1 < c1) P3_PUTU(ru_b);
                    if (c + 3 < c1) P3_LOAD(rb, ru_b, c + 3);
                    P3_BAR();
                    if (c + 2 < c1) P3_PUT(ra, 0);
                    P3_OCOPY(c);
                    P3_BAR();
                    if (c + 2 < c1) P3_PUTU(ru_a);
                    if (c + 4 < c1) P3_LOAD(ra, ru_a, c + 4);
                    P3_BAR();
                }
                P3_OCOPY(c1 - 1);
#undef P3_LOAD
#undef P3_PUT
#undef P3_PUTU
#undef P3_OCOPY
#undef P3_BAR
            }
        }
}

struct Args { const float* in[18]; float* out; unsigned char* ws; int ph_lo, ph_hi; };

template <unsigned PMASK> __global__ void __launch_bounds__(NWAVES * 64, 2) fwd(Args args) {
    extern __shared__ __attribute__((aligned(16))) unsigned char lds_raw[];
    LAS unsigned char* lds = (LAS unsigned char*)lds_raw;
    const int wave = __builtin_amdgcn_readfirstlane((int)threadIdx.x >> 6);
#define PHASE_IDS const int lane = lane_id_v(), tid = wave * 64 + lane; (void)tid; (void)lane
    const int G = gridDim.x, gw = blockIdx.x * NWAVES + wave, NGW = G * NWAVES;
    unsigned char* ws = args.ws;
    const float* x = args.in[0]; const float* norm1_w = args.in[1]; const float* w_in = args.in[2]; const float* conv_qkv_w = args.in[3];
    const float* a_log = args.in[4]; const float* dt_bias = args.in[5]; const float* gdn_norm_w = args.in[6]; const float* conv_sc_w = args.in[7];
    const float* w_out = args.in[8]; const float* norm2_w = args.in[9]; const float* rgw = args.in[10]; const float* rgb = args.in[11];
    const float* rew = args.in[12]; const float* reb = args.in[13]; const float* w_gate = args.in[14]; const float* w_up = args.in[15];
    const float* w_down = args.in[16]; const float* final_w = args.in[17];
    float* out = args.out;
    float* BA = (float*)(ws + WS_BA); float* GB = (float*)(ws + WS_GB); float* RSTD = (float*)(ws + WS_RSTD);
    int* EID = (int*)(ws + WS_EID); float* GATE = (float*)(ws + WS_GATE); int* POS = (int*)(ws + WS_POS);
    float* ROWSC = (float*)(ws + WS_ROWSC); int* ROWTOK = (int*)(ws + WS_ROWTOK); float* ROWGATE = (float*)(ws + WS_ROWGATE); int* TILES = (int*)(ws + WS_TILES);
    bf16* WIN = (bf16*)(ws + WS_WIN); bf16* WOUT = (bf16*)(ws + WS_WOUT);
    bf16* HN = (bf16*)(ws + WS_R0); bf16* Y = (bf16*)(ws + WS_R0); bf16* HID = (bf16*)(ws + WS_R0);
    bf16* PROJ = (bf16*)(ws + WS_R1); bf16* WGU = (bf16*)(ws + WS_R1); bf16* WDN = (bf16*)(ws + WS_R1 + 320 * MiB);
    float* SBUF = (float*)(ws + WS_SBUF); unsigned char* GI = ws + WS_R3; int* CNT = (int*)(ws + WS_CTL + 65536);     bf16* WR = (bf16*)(ws + WS_WR); float* SSQ = (float*)(ws + WS_SSQ); bf16* H1B = (bf16*)(ws + WS_H1B); float* DSC = (float*)(ws + WS_DSC); bf16* XG = (bf16*)(ws + WS_R3); bf16* YMOE = (bf16*)(ws + WS_R3);
    const int lo = args.ph_lo, hi = args.ph_hi;
    { PHASE_IDS; for (int u = tid; u < (LDS_BYTES - LDSCTL_OFF) / 4; u += NWAVES * 64) ((LAS unsigned*)(lds + LDSCTL_OFF))[u] = 0u; }
    __syncthreads();
    XcdBarrier bar; bar.bar = (unsigned*)(ws + WS_CTL) + 4096; bar.x = 0; bar.st = nullptr; bar.wv = wave;
    if (hi - lo > 1) bar = xcd_barrier_post((unsigned*)(ws + WS_CTL) + 4096, (volatile LAS unsigned*)(lds + MISC_OFF) + 8, wave);
    const unsigned bar_x = __builtin_amdgcn_readfirstlane(bar.x);
#define SEAM(k) do { if (IN(k) && IN((k) + 1)) { unsigned* bp_ = (unsigned*)(ws + WS_CTL) + 4096; asm volatile("" : "+s"(bp_)); XcdBarrier b_; b_.bar = bp_; b_.x = bar_x; b_.st = (volatile LAS unsigned*)(lds + MISC_OFF) + 8; b_.wv = wave; xcd_barrier(b_); } } while (0)
#ifndef PROBE_MASK
#define PROBE_MASK 0u
#endif
#define SEAM_ALWAYS do { unsigned* bp_ = (unsigned*)(ws + WS_CTL) + 4096; asm volatile("" : "+s"(bp_)); XcdBarrier b_; b_.bar = bp_; b_.x = bar_x; b_.st = (volatile LAS unsigned*)(lds + MISC_OFF) + 8; b_.wv = wave; xcd_barrier(b_); } while (0)
#define PH_BEGIN(k) _Pragma("unroll") for (int rep_ = 0; rep_ < (((PROBE_MASK >> (k)) & 1u) ? 2 : 1); ++rep_) if (IN(k)) { if (rep_ > 0) SEAM_ALWAYS;
#define IN(k) (((PMASK >> (k)) & 1u) && lo <= (k) && (k) < hi)

    PH_BEGIN(0)
        PHASE_IDS;
        LAS float* scr = (LAS float*)(lds + wave * 16640);
        constexpr int I_IN = (D / 64) * (NPROJ / 64), I_OUT = (D / 64) * (D / 64);
        for (int it = gw; it < I_IN + I_OUT; it += NGW) {
            if (it < I_IN) { const int kb = it / (NPROJ / 64), nb = it % (NPROJ / 64), n0 = nb * 64; transpose_item(w_in, IN_COLS, n0 < 4096 ? n0 : n0 + 16, kb * 64, WIN, D, n0, scr, lane, nullptr); }
            else { const int r = it - I_IN, kb = r / (D / 64), nb = r % (D / 64); transpose_item(w_out, D, nb * 64, kb * 64, WOUT, D, nb * 64, scr, lane, nullptr); }
        }
        for (int item = wave * G + (int)blockIdx.x; item < 320; item += NGW) {
            if (item < 256) { const int k0 = item * 8; float v[8];
#pragma unroll
                for (int j = 0; j < 8; ++j) v[j] = rew[(size_t)(k0 + j) * 64 + lane] * norm2_w[k0 + j];
                v4u o; o.x = pk2(v[0], v[1]); o.y = pk2(v[2], v[3]); o.z = pk2(v[4], v[5]); o.w = pk2(v[6], v[7]);
                *(v4u*)(WR + (size_t)(8 + lane) * D + k0) = o; }
            else if (item < 288) { const int p = (item - 256) * 64 + lane, gq = p & 7, k0 = (p >> 3) * 8; float v[8];
#pragma unroll
                for (int j = 0; j < 8; ++j) v[j] = rgw[(size_t)(k0 + j) * 8 + gq] * norm2_w[k0 + j];
                v4u o; o.x = pk2(v[0], v[1]); o.y = pk2(v[2], v[3]); o.z = pk2(v[4], v[5]); o.w = pk2(v[6], v[7]);
                *(v4u*)(WR + (size_t)gq * D + k0) = o; }
            else { const int p = (item - 288) * 64 + lane; *(v4u*)(WR + (size_t)(72 + (p >> 8)) * D + (p & 255) * 8) = (v4u){0u, 0u, 0u, 0u}; }
        }
        __syncthreads();
        LAS bf16* wbl = (LAS bf16*)lds;
        for (int idx = tid; idx < 16 * D; idx += NWAVES * 64) { const int k = idx >> 4, c = idx & 15; wbl[c * 2056 + k] = (bf16)f2bf(w_in[(size_t)k * IN_COLS + 4096 + c]); }
        __syncthreads();
        for (int blk = gw; blk < T / 16; blk += NGW) {
#define P0_RW(r_) ((r_) * (T / 16) + blk)
            f32x4 nxa[8], nxb[8];
#define P0_LD(dst, rowi) do { const f32x4* xr_ = (const f32x4*)(x + (size_t)(rowi) * D) + lane; _Pragma("unroll") for (int j = 0; j < 8; ++j) dst[j] = xr_[64 * j]; } while (0)
#define P0_ROW(src, m_) do { f32x4 v[8]; float ss = 0.f; \
                _Pragma("unroll") for (int j = 0; j < 8; ++j) { v[j] = src[j]; ss += (v[j].x * v[j].x + v[j].y * v[j].y) + (v[j].z * v[j].z + v[j].w * v[j].w); } \
                const float rstd = rsqrtf(wave_sum(ss) * (1.f / D) + EPS); v2u* o8 = (v2u*)(HN + (size_t)(m_) * D) + lane; \
                _Pragma("unroll") for (int j = 0; j < 8; ++j) { v[j] = v[j] * rstd * wn1[j]; v2u o; o.x = cvtpk(v[j].x, v[j].y); o.y = cvtpk(v[j].z, v[j].w); o8[64 * j] = o; } } while (0)
            f32x4 wn1[8];
#pragma unroll
            for (int j = 0; j < 8; ++j) wn1[j] = *((const f32x4*)norm1_w + lane + 64 * j);
            P0_LD(nxa, P0_RW(0)); P0_LD(nxb, P0_RW(1));
#pragma unroll 1
            for (int r = 0; r < 16; r += 2) {
                { f32x4 cur[8];
#pragma unroll
                  for (int j = 0; j < 8; ++j) cur[j] = nxa[j];
                  if (r + 2 < 16) P0_LD(nxa, P0_RW(r + 2));
                  P0_ROW(cur, P0_RW(r)); }
                { f32x4 cur[8];
#pragma unroll
                  for (int j = 0; j < 8; ++j) cur[j] = nxb[j];
                  if (r + 3 < 16) P0_LD(nxb, P0_RW(r + 3));
                  P0_ROW(cur, P0_RW(r + 1)); }
            }
#undef P0_LD
#undef P0_ROW
            asm volatile("s_waitcnt vmcnt(0)" ::: "memory");
            { const int fr = lane & 15, fg = lane >> 4;
              pg8::f32x4 acc = (pg8::f32x4){0.f, 0.f, 0.f, 0.f};
              const bf16* ap = HN + (size_t)P0_RW(fr) * D + 8 * fg; const LAS bf16* bp = wbl + fr * 2056 + 8 * fg;
#pragma unroll 1
              for (int k0 = 0; k0 < D; k0 += 256) {
                  pg8::bf16x8 a[8];
#pragma unroll
                  for (int u = 0; u < 8; ++u) a[u] = *(const pg8::bf16x8*)(ap + k0 + 32 * u);
#pragma unroll
                  for (int u = 0; u < 8; ++u) { const pg8::bf16x8 bq = *(const LAS pg8::bf16x8*)(bp + k0 + 32 * u); acc = __builtin_amdgcn_mfma_f32_16x16x32_bf16(a[u], bq, acc, 0, 0, 0); }
              }
#pragma unroll
              for (int r = 0; r < 4; ++r) BA[(size_t)P0_RW(4 * fg + r) * 16 + fr] = acc[r]; }
#undef P0_RW
        }
    }

    SEAM(0);
    PH_BEGIN(1)
        PHASE_IDS;
        pg8::Gemm g{HN, WIN, T, NPROJ, D}; pg8::StaticOrder S; S.init(T, NPROJ, G, (int)blockIdx.x);
        pg8::EpiBf16S E{PROJ, 1024, 1024, PROJ_T};
        pg8::gemm_phase<pg8::EpiBf16S, pg8::StaticOrder, PG8_ALIGN, PG8_SP2>(lds + RING_OFF, g, S, E, wave);
    }

    SEAM(1);
    PH_BEGIN(2)
        PHASE_IDS;
        const bf16* PB = PROJ + 4 * PROJ_T; const bf16* PC = PROJ + 5 * PROJ_T; const bf16* PH = PROJ + 6 * PROJ_T;
        f32x4 scw[3][4];
#pragma unroll
        for (int j = 0; j < 3; ++j) { const f32x4* wp = (const f32x4*)(conv_sc_w + (size_t)j * 1024 + 16 * lane); scw[j][0] = wp[0]; scw[j][1] = wp[1]; scw[j][2] = wp[2]; scw[j][3] = wp[3]; }
        for (int t = gw; t < T; t += NGW) {
            const int tt = t % SEQ, c0 = 16 * lane;
            float acc[16];
#pragma unroll
            for (int i = 0; i < 16; ++i) acc[i] = 0.f;
#pragma unroll
            for (int j = 0; j < 3; ++j) {
                if (tt - 2 + j >= 0) {
                    const v4u* pc = (const v4u*)(PC + (size_t)(t - 2 + j) * 1024 + c0); const v4u* ph = (const v4u*)(PH + (size_t)(t - 2 + j) * 1024 + c0);
                    const v4u a = pc[0], b = pc[1], e = ph[0], f = ph[1];
                    const f32x4 w0 = scw[j][0], w1 = scw[j][1], w2 = scw[j][2], w3 = scw[j][3];
                    acc[0] += bflo(a.x) * bflo(e.x) * w0.x; acc[1] += bfhi(a.x) * bfhi(e.x) * w0.y; acc[2] += bflo(a.y) * bflo(e.y) * w0.z; acc[3] += bfhi(a.y) * bfhi(e.y) * w0.w;
                    acc[4] += bflo(a.z) * bflo(e.z) * w1.x; acc[5] += bfhi(a.z) * bfhi(e.z) * w1.y; acc[6] += bflo(a.w) * bflo(e.w) * w1.z; acc[7] += bfhi(a.w) * bfhi(e.w) * w1.w;
                    acc[8] += bflo(b.x) * bflo(f.x) * w2.x; acc[9] += bfhi(b.x) * bfhi(f.x) * w2.y; acc[10] += bflo(b.y) * bflo(f.y) * w2.z; acc[11] += bfhi(b.y) * bfhi(f.y) * w2.w;
                    acc[12] += bflo(b.z) * bflo(f.z) * w3.x; acc[13] += bfhi(b.z) * bfhi(f.z) * w3.y; acc[14] += bflo(b.w) * bflo(f.w) * w3.z; acc[15] += bfhi(b.w) * bfhi(f.w) * w3.w;
                }
            }
            const v4u* pb = (const v4u*)(PB + (size_t)t * 1024 + c0); const v4u a = pb[0], b = pb[1];
            v4u o0, o1;
            o0.x = pk2(acc[0] * bflo(a.x), acc[1] * bfhi(a.x)); o0.y = pk2(acc[2] * bflo(a.y), acc[3] * bfhi(a.y)); o0.z = pk2(acc[4] * bflo(a.z), acc[5] * bfhi(a.z)); o0.w = pk2(acc[6] * bflo(a.w), acc[7] * bfhi(a.w));
            o1.x = pk2(acc[8] * bflo(b.x), acc[9] * bfhi(b.x)); o1.y = pk2(acc[10] * bflo(b.y), acc[11] * bfhi(b.y)); o1.z = pk2(acc[12] * bflo(b.z), acc[13] * bfhi(b.z)); o1.w = pk2(acc[14] * bflo(b.w), acc[15] * bfhi(b.w));
            v4u* dst = (v4u*)(Y + (size_t)t * D + 1024 + c0); dst[0] = o0; dst[1] = o1;
        }
        gdn_prep(lds, wave, (int)blockIdx.x, G, 0, GDN_SPLIT, PROJ, conv_qkv_w, BA, a_log, dt_bias, GI, DSC);
    }

    SEAM(2);
    PH_BEGIN(3)
#define P3_NJA 19200
#define P3_ITEM(isA_, it_) do { const int it = (it_); \
                if ((isA_) && it < 16384) { const int e = it >> 8, r = it & 255, kb = r >> 5, nb = r & 31; \
                    transpose_item(w_down + (size_t)e * DE * D, D, nb * 64, kb * 64, WDN, DE, e * 2048 + nb * 64, scr, lane, nullptr); } \
                else { const int q = (isA_) ? it - 16384 : it; const int e = ((isA_) ? 48 : 0) + (q >> 9); int r = q & 511; const int up = r >> 8; r &= 255; const int kb = r >> 3, nb = r & 7, n0 = nb * 64; \
                    transpose_item((up ? w_up : w_gate) + (size_t)e * D * DE, DE, n0, kb * 64, WGU, D, (e * 4 + (e >= 48 ? 64 : 0) + (n0 >> 7)) * 256 + up * 128 + (n0 & 127), scr, lane, norm2_w); } } while (0)
#define P3_CONVERT(part) do { const int lane = lane_id_v(); LAS float* scr = (LAS float*)(lds + wave * 16640); \
            const int nh = G - NSCAN, hidx = (int)blockIdx.x - NSCAN, cw = hidx * NWAVES + wave, ncw = nh * NWAVES; \
            constexpr int NJA = P3_NJA; const int NJ = (part) == 0 ? NJA : 24576 + (24576 - NJA), EXTRA = (part) == 0 ? 2 : 4; \
            const int heavy = (part) == 0 ? (((SEQ / 64 - GDN_SPLIT) * BATCH * NH) % nh) : (((T / 256) * (D / 256)) % nh);     \
            const int nlw = (nh - heavy) * NWAVES; int R = heavy ? (NJ - EXTRA * nlw) / ncw : (NJ + ncw - 1) / ncw; if (R < 0) R = 0; \
            for (int k = 0; k < R; ++k) { const int J = cw + k * ncw; if (J < NJ) { if ((part) == 0) P3_ITEM(1, J); else if (J < 24576) P3_ITEM(0, J); else P3_ITEM(1, NJA + (J - 24576)); } } \
            if (heavy && hidx >= heavy) for (int J = R * ncw + (hidx - heavy) * NWAVES + wave; J < NJ; J += nlw) { if ((part) == 0) P3_ITEM(1, J); else if (J < 24576) P3_ITEM(0, J); else P3_ITEM(1, NJA + (J - 24576)); } } while (0)
        if (blockIdx.x < NSCAN) gdn_scan(lds, wave, (int)blockIdx.x & 15, (int)blockIdx.x >> 4, 0, GDN_SPLIT, GI, DSC, Y, SBUF);
        else {
            const bool copy_first = ((int)blockIdx.x & 1) != 0;
#pragma unroll 1
            for (int ph = 0; ph < 2; ++ph) {
                if ((ph == 0) != copy_first) gdn_prep(lds, wave, (int)blockIdx.x - NSCAN, G - NSCAN, GDN_SPLIT, SEQ / 64, PROJ, conv_qkv_w, BA, a_log, dt_bias, GI, DSC);
                else P3_CONVERT(0);
                __syncthreads();
            } }
        SEAM_ALWAYS;
        if (blockIdx.x < NSCAN) {
            gdn_scan(lds, wave, (int)blockIdx.x & 15, (int)blockIdx.x >> 4, GDN_SPLIT, SEQ / 64, GI, DSC, Y, SBUF);
        } else {
            const bool copy_first = ((int)blockIdx.x & 1) != 0;
#pragma unroll 1
            for (int ph = 0; ph < 2; ++ph) {
                if ((ph == 0) == copy_first) P3_CONVERT(1);
                else {
                    pg8::Gemm g{Y + 1024, WOUT + 1024, T, D, 1024, D}; pg8::StaticOrder S; S.init(T, D, G - NSCAN, (int)blockIdx.x - NSCAN);
                    pg8::EpiResB16 E{x, (bf16*)out, D};
                    pg8::gemm_phase<pg8::EpiResB16, pg8::StaticOrder, PG8_ALIGN, PG8_SP2>(lds + RING_OFF, g, S, E, wave); }
                __syncthreads();
            }
        }
    }

#undef P3_CONVERT
#undef P3_ITEM
    SEAM(3);
    PH_BEGIN(4)
        PHASE_IDS;
        {
            const bf16* Zt = PROJ + 3 * PROJ_T;
            const f32x4* nwp = (const f32x4*)(gdn_norm_w + 16 * (lane & 7)); const f32x4 n0 = nwp[0], n1 = nwp[1], n2 = nwp[2], n3 = nwp[3];
            v4u noa = (v4u){0u, 0u, 0u, 0u}, nob = noa, nza = noa, nzb = noa, n2oa = noa, n2ob = noa, n2za = noa, n2zb = noa;
            if (gw < T) { const v4u* yp0 = (const v4u*)(Y + (size_t)gw * D + 16 * lane); const v4u* zp0 = (const v4u*)(Zt + (size_t)gw * 1024 + 16 * lane); noa = yp0[0]; nob = yp0[1]; nza = zp0[0]; nzb = zp0[1]; }
            if (gw + NGW < T) { const v4u* yp0 = (const v4u*)(Y + (size_t)(gw + NGW) * D + 16 * lane); const v4u* zp0 = (const v4u*)(Zt + (size_t)(gw + NGW) * 1024 + 16 * lane); n2oa = yp0[0]; n2ob = yp0[1]; n2za = zp0[0]; n2zb = zp0[1]; }
            for (int t = gw; t < T; t += NGW) {
                v4u* yp = (v4u*)(Y + (size_t)t * D + 16 * lane);
                const v4u oa = noa, ob = nob, za = nza, zb = nzb;
                noa = n2oa; nob = n2ob; nza = n2za; nzb = n2zb;
                if (t + 2 * NGW < T) { const v4u* yp1 = (const v4u*)(Y + (size_t)(t + 2 * NGW) * D + 16 * lane); const v4u* zp1 = (const v4u*)(Zt + (size_t)(t + 2 * NGW) * 1024 + 16 * lane); n2oa = yp1[0]; n2ob = yp1[1]; n2za = zp1[0]; n2zb = zp1[1]; }
                float o[16] = {bflo(oa.x), bfhi(oa.x), bflo(oa.y), bfhi(oa.y), bflo(oa.z), bfhi(oa.z), bflo(oa.w), bfhi(oa.w), bflo(ob.x), bfhi(ob.x), bflo(ob.y), bfhi(ob.y), bflo(ob.z), bfhi(ob.z), bflo(ob.w), bfhi(ob.w)};
                const float z[16] = {bflo(za.x), bfhi(za.x), bflo(za.y), bfhi(za.y), bflo(za.z), bfhi(za.z), bflo(za.w), bfhi(za.w), bflo(zb.x), bfhi(zb.x), bflo(zb.y), bfhi(zb.y), bflo(zb.z), bfhi(zb.z), bflo(zb.w), bfhi(zb.w)};
                const float nwv[16] = {n0.x, n0.y, n0.z, n0.w, n1.x, n1.y, n1.z, n1.w, n2.x, n2.y, n2.z, n2.w, n3.x, n3.y, n3.z, n3.w};
                float ss = 0.f;
#pragma unroll
                for (int i = 0; i < 16; ++i) ss += o[i] * o[i];
                ss += __shfl_xor(ss, 1); ss += __shfl_xor(ss, 2); ss += __shfl_xor(ss, 4);
                const float rs = rsqrtf(ss * (1.f / 128.f) + EPS);
#pragma unroll
                for (int i = 0; i < 16; ++i) o[i] = o[i] * rs * nwv[i] * siluf(z[i]);
                v4u ya, yb; ya.x = cvtpk(o[0], o[1]); ya.y = cvtpk(o[2], o[3]); ya.z = cvtpk(o[4], o[5]); ya.w = cvtpk(o[6], o[7]); yb.x = cvtpk(o[8], o[9]); yb.y = cvtpk(o[10], o[11]); yb.z = cvtpk(o[12], o[13]); yb.w = cvtpk(o[14], o[15]);
                yp[0] = ya; yp[1] = yb;
            }
        }
        SEAM_ALWAYS;
        pg8::Gemm g{Y, WOUT, T, D, 1024, D}; pg8::StaticOrder S; S.init(T, D, G, (int)blockIdx.x);
        pg8::EpiRes2 E{(const bf16*)out, H1B, SSQ, D};
        pg8::gemm_phase<pg8::EpiRes2, pg8::StaticOrder, PG8_ALIGN, PG8_SP2>(lds + RING_OFF, g, S, E, wave);
    }

    SEAM(4);
    PH_BEGIN(5)
        PHASE_IDS;
        constexpr int BP = 264;
        LAS bf16* Bs0 = (LAS bf16*)lds; LAS bf16* Bs1 = (LAS bf16*)(lds + 43008);
        for (int wt = blockIdx.x; wt < T / 128; wt += G) {
            const int row0 = wt * 128 + wave * 16, fr = lane & 15, fg = lane >> 4;
            pg8::f32x4 acc[5];
#pragma unroll
            for (int n = 0; n < 5; ++n) acc[n] = (pg8::f32x4){0.f, 0.f, 0.f, 0.f};
            const bf16* ap = H1B + (size_t)(row0 + fr) * D + 8 * fg;
            v4u sb[5]; pg8::bf16x8 a[8], an[8];
#define P5_LOADB(s_) do { _Pragma("unroll") for (int i = 0; i < 5; ++i) { const int p_ = tid + NWAVES * 64 * i; sb[i] = *(const v4u*)(WR + (size_t)(p_ >> 5) * D + (s_) * 256 + (p_ & 31) * 8); } } while (0)
#define P5_PUTB(buf_) do { _Pragma("unroll") for (int i = 0; i < 5; ++i) { const int p_ = tid + NWAVES * 64 * i; *(LAS v4u*)((buf_) + (p_ >> 5) * BP + (p_ & 31) * 8) = sb[i]; } } while (0)
#define P5_LOADA(dst_, s_) do { _Pragma("unroll") for (int u = 0; u < 8; ++u) dst_[u] = *(const pg8::bf16x8*)(ap + (s_) * 256 + 32 * u); } while (0)
            P5_LOADB(0); P5_LOADA(an, 0); P5_PUTB(Bs0);
            asm volatile("s_waitcnt lgkmcnt(0)" ::: "memory"); __builtin_amdgcn_s_barrier(); asm volatile("" ::: "memory");
#pragma unroll 1
            for (int sl = 0; sl < 8; ++sl) {
                LAS bf16* cur = (sl & 1) ? Bs1 : Bs0; LAS bf16* nxt = (sl & 1) ? Bs0 : Bs1;
#pragma unroll
                for (int u = 0; u < 8; ++u) a[u] = an[u];
                if (sl + 1 < 8) { P5_LOADB(sl + 1); P5_LOADA(an, sl + 1); }
                const LAS bf16* bp = cur + fr * BP + 8 * fg;
#pragma unroll
                for (int u = 0; u < 8; ++u)
#pragma unroll
                    for (int n = 0; n < 5; ++n) { const pg8::bf16x8 bq = *(const LAS pg8::bf16x8*)(bp + (16 * n) * BP + 32 * u); acc[n] = __builtin_amdgcn_mfma_f32_16x16x32_bf16(a[u], bq, acc[n], 0, 0, 0); }
                if (sl + 1 < 8) P5_PUTB(nxt);
                asm volatile("s_waitcnt lgkmcnt(0)" ::: "memory"); __builtin_amdgcn_s_barrier(); asm volatile("" ::: "memory");
            }
#undef P5_LOADB
#undef P5_PUTB
#undef P5_LOADA
            LAS float* LG = (LAS float*)(lds + 86016) + wave * (16 * 84);
#pragma unroll
            for (int n = 0; n < 5; ++n)
#pragma unroll
                for (int r = 0; r < 4; ++r) LG[(4 * fg + r) * 84 + 16 * n + fr] = acc[n][r];
            float rsl;
            { const f32x4* sp = (const f32x4*)(SSQ + (size_t)(row0 + fr) * 32); f32x4 a4 = sp[0];
#pragma unroll
              for (int q = 1; q < 8; ++q) a4 += sp[q];
              rsl = rsqrtf(((a4.x + a4.y) + (a4.z + a4.w)) * (1.f / 2048.f) + EPS); }
            LDS_WAIT(); asm volatile("" ::: "memory");
            int mycnt = 0;
#pragma unroll 1
            for (int rr = 0; rr < 16; ++rr) {
                const int t = row0 + rr; const float rs = __shfl(rsl, rr);
                const float gl = LG[rr * 84 + (lane & 7)] * rs + rgb[lane & 7], el = LG[rr * 84 + 8 + lane] * rs + reb[lane];
                float gm = gl; gm = fmaxf(gm, __shfl_xor(gm, 1)); gm = fmaxf(gm, __shfl_xor(gm, 2)); gm = fmaxf(gm, __shfl_xor(gm, 4));
                int gi = (gl == gm) ? (lane & 7) : 8; gi = min(gi, __shfl_xor(gi, 1)); gi = min(gi, __shfl_xor(gi, 2)); gi = min(gi, __shfl_xor(gi, 4));
                float gsum = __expf(gl - gm); gsum += __shfl_xor(gsum, 1); gsum += __shfl_xor(gsum, 2); gsum += __shfl_xor(gsum, 4);
                gi = __builtin_amdgcn_readfirstlane(gi); const float gwt = 1.0f / gsum;
                const float v = __shfl(el, gi * 8 + (lane & 7));
                float m1 = v; m1 = fmaxf(m1, __shfl_xor(m1, 1)); m1 = fmaxf(m1, __shfl_xor(m1, 2)); m1 = fmaxf(m1, __shfl_xor(m1, 4));
                int i1 = (v == m1) ? (lane & 7) : 8; i1 = min(i1, __shfl_xor(i1, 1)); i1 = min(i1, __shfl_xor(i1, 2)); i1 = min(i1, __shfl_xor(i1, 4));
                const float v2 = ((lane & 7) == i1) ? -3.0e38f : v;
                float m2 = v2; m2 = fmaxf(m2, __shfl_xor(m2, 1)); m2 = fmaxf(m2, __shfl_xor(m2, 2)); m2 = fmaxf(m2, __shfl_xor(m2, 4));
                int i2 = (v2 == m2) ? (lane & 7) : 8; i2 = min(i2, __shfl_xor(i2, 1)); i2 = min(i2, __shfl_xor(i2, 2)); i2 = min(i2, __shfl_xor(i2, 4));
                const float e2 = __expf(m2 - m1), inv = 1.0f / (1.0f + e2);
                const int e_a = gi * 8 + __builtin_amdgcn_readfirstlane(i1), e_b = gi * 8 + __builtin_amdgcn_readfirstlane(i2);
                mycnt += (lane == e_a) + (lane == e_b);
                if (lane == 0) { EID[t * 2] = e_a; EID[t * 2 + 1] = e_b; GATE[t * 2] = gwt * inv; GATE[t * 2 + 1] = gwt * e2 * inv; RSTD[t] = rs; }
            }
            if (mycnt) atomicAdd(&CNT[(row0 >> 8) * 64 + lane], mycnt);
            LDS_WAIT(); asm volatile("" ::: "memory");
        }
    }

    SEAM(5);
    PH_BEGIN(6)
        PHASE_IDS;
        if (blockIdx.x < T / 256) {
            const int w = blockIdx.x;
            LAS int* ptot = (LAS int*)lds; LAS int* pbef = ptot + 512; LAS int* basel = pbef + 512; LAS int* eidl = basel + 64; LAS int* posl = eidl + 512; LAS int* totl = posl + 512; LAS int* startl = totl + 64;
            { const int e = tid & 63, part = tid >> 6; int st = 0, sb = 0;
              for (int q = 0; q < 16; ++q) { const int wp = part * 16 + q; const int cv = CNT[wp * 64 + e]; st += cv; sb += (wp < w) ? cv : 0; }
              ptot[part * 64 + e] = st; pbef[part * 64 + e] = sb; }
            eidl[tid] = EID[w * 512 + tid];
            __syncthreads();
            if (wave == 0) {
                int tot = 0, bef = 0;
#pragma unroll
                for (int p = 0; p < 8; ++p) { tot += ptot[p * 64 + lane]; bef += pbef[p * 64 + lane]; }
                const int pc = ((tot + 255) >> 8) << 8; int incl = pc;
#pragma unroll
                for (int o = 1; o < 64; o <<= 1) { const int v = __shfl_up(incl, o); if (lane >= o) incl += v; }
                const int start = incl - pc;
                basel[lane] = start + bef; totl[lane] = tot; startl[lane] = start;
                if (w == 0) { for (int r = 0; r < (pc >> 8); ++r) TILES[64 + (start >> 8) + r] = lane; if (lane == 63) TILES[0] = incl >> 8; }
            }
            LAS int* wcnt = startl + 64;
            wcnt[tid] = 0;
            __syncthreads();
            const int mye = eidl[tid]; int rk = 0;
#pragma unroll 8
            for (int l = 0; l < 64; ++l) { const int el = __builtin_amdgcn_readlane(mye, l); rk += (l < lane && el == mye) ? 1 : 0; }
            atomicAdd((int*)&wcnt[wave * 64 + mye], 1);
            __syncthreads();
            { int off = 0;
              for (int w2 = 0; w2 < wave; ++w2) off += wcnt[w2 * 64 + mye];
              const int a = w * 512 + tid; const int p = basel[mye] + off + rk; ROWTOK[p] = a >> 1; ROWGATE[p] = GATE[a]; ROWSC[p] = RSTD[a >> 1]; POS[a] = p; }
            if (w < NE) { const int e = w; const int s0 = startl[e] + totl[e], s1 = startl[e] + (((totl[e] + 255) >> 8) << 8);
                for (int p = s0 + tid; p < s1; p += NWAVES * 64) { ROWTOK[p] = 0; ROWGATE[p] = 0.f; ROWSC[p] = 0.f; } }
        }
    }

    PH_BEGIN(7)
    }

    SEAM(7);
    PH_BEGIN(8)
        PHASE_IDS;
        LAS int* rt = (LAS int*)(lds + RING_BYTES);
        LAS float* rsc = (LAS float*)(lds + RING_BYTES + 8192);
        LAS int* te = (LAS int*)(lds + RING_BYTES + 16384);
        const int ntl = TILES[0];
        for (int i = tid; i < ntl; i += NWAVES * 64) te[i] = TILES[64 + i];
        __syncthreads();
        pg8::Gemm g{H1B, WGU, CAP_ROWS, NE * 1024, D}; pg8::MoeOrder S{te, ntl, 4, G, (int)blockIdx.x, 48, 64};
        { pg8::Unit uu; for (int i = 0; i < 8 && S.next(i, uu); ++i) { if (tid < 256) rt[i * 256 + tid] = ROWTOK[uu.pm * 256 + tid]; else rsc[i * 256 + tid - 256] = ROWSC[uu.pm * 256 + tid - 256]; } }
        __syncthreads();
        pg8::EpiSwiGLU E{HID, rsc};
        pg8::gemm_phase<pg8::EpiSwiGLU, pg8::MoeOrder, PG8_ALIGN, PG8_SP2, true>(lds + RING_OFF, g, S, E, wave, rt);
    }
    SEAM(8);
    PH_BEGIN(9)
        PHASE_IDS;
        LAS float* rgt = (LAS float*)(lds + RING_BYTES);
        LAS int* te = (LAS int*)(lds + RING_BYTES + 16384);
        const int ntl = TILES[0];
        for (int i = tid; i < ntl; i += NWAVES * 64) te[i] = TILES[64 + i];
        __syncthreads();
        pg8::Gemm g{HID, WDN, CAP_ROWS, NE * 2048, DE}; pg8::MoeOrder S{te, ntl, 8, G, (int)blockIdx.x, 1 << 30, 0};
        { pg8::Unit uu; for (int i = 0; i < 12 && S.next(i, uu); ++i) { if (tid < 256) rgt[i * 256 + tid] = ROWGATE[uu.pm * 256 + tid]; } }
        __syncthreads();
        pg8::EpiDown E{YMOE, rgt};
        pg8::gemm_phase<pg8::EpiDown, pg8::MoeOrder, PG8_ALIGN, PG8_SP2>(lds + RING_OFF, g, S, E, wave);
    }
    SEAM(9);
    PH_BEGIN(10)
        PHASE_IDS;
        {
            v2u na[8], nb[8], nh[8]; int q0 = 0, q1 = 0;
            f32x4 fwv[8];
#pragma unroll
            for (int j = 0; j < 8; ++j) fwv[j] = *((const f32x4*)final_w + lane + 64 * j);
#define P10_LOAD(tt, p0_, p1_) do { const v2u* hb_ = (const v2u*)(H1B + (size_t)(tt) * D) + lane; const v2u* y0_ = (const v2u*)(YMOE + (size_t)(p0_) * D) + lane; const v2u* y1_ = (const v2u*)(YMOE + (size_t)(p1_) * D) + lane; \
        _Pragma("unroll") for (int j = 0; j < 8; ++j) { na[j] = y0_[64 * j]; nb[j] = y1_[64 * j]; nh[j] = hb_[64 * j]; } } while (0)
            if (gw < T) { P10_LOAD(gw, POS[gw * 2], POS[gw * 2 + 1]); }
            if (gw + NGW < T) { q0 = POS[(gw + NGW) * 2]; q1 = POS[(gw + NGW) * 2 + 1]; }
            for (int t = gw; t < T; t += NGW) {
                f32x4 v[8]; float ss = 0.f;
#pragma unroll
                for (int j = 0; j < 8; ++j) { const v2u a = na[j], b = nb[j], hh = nh[j];
                    v[j].x = bflo(hh.x) + (bflo(a.x) + bflo(b.x)); v[j].y = bfhi(hh.x) + (bfhi(a.x) + bfhi(b.x)); v[j].z = bflo(hh.y) + (bflo(a.y) + bflo(b.y)); v[j].w = bfhi(hh.y) + (bfhi(a.y) + bfhi(b.y));
                    ss += (v[j].x * v[j].x + v[j].y * v[j].y) + (v[j].z * v[j].z + v[j].w * v[j].w); }
                if (t + NGW < T) { P10_LOAD(t + NGW, q0, q1); }
                if (t + 2 * NGW < T) { q0 = POS[(t + 2 * NGW) * 2]; q1 = POS[(t + 2 * NGW) * 2 + 1]; }
                const float rstd = rsqrtf(wave_sum(ss) * (1.f / D) + EPS);
                f32x4* hr = (f32x4*)(out + (size_t)t * D) + lane;
#pragma unroll
                for (int j = 0; j < 8; ++j) hr[64 * j] = v[j] * rstd * fwv[j];
            }
#undef P10_LOAD
        }
    }
#undef IN
#undef SEAM
}

template <unsigned PM> static bool setup_kernel(int& per_cu) {
    if (hipFuncSetAttribute((const void*)fwd<PM>, hipFuncAttributeMaxDynamicSharedMemorySize, LDS_BYTES) != hipSuccess) return false;
    int pc = 0; if (hipOccupancyMaxActiveBlocksPerMultiprocessor(&pc, (const void*)fwd<PM>, NWAVES * 64, LDS_BYTES) != hipSuccess) pc = 0;
    per_cu = pc; (void)hipGetLastError(); return true;
}
template <unsigned PM> static void launch_phase(int grid, hipStream_t stream, Args a, int ph) { a.ph_lo = ph; a.ph_hi = ph + 1; hipLaunchKernelGGL(fwd<PM>, dim3(grid), dim3(NWAVES * 64), LDS_BYTES, stream, a); }
extern "C" void kernel_launch(void* const* d_in, const int* in_sizes, int n_in, void* d_out, int out_size, void* d_ws, size_t ws_size, hipStream_t stream) {
    static int grid = 0;
    if (grid == 0) {
        if (n_in != 18 || in_sizes[0] != T * D || out_size != T * D || ws_size < WS_END) { fprintf(stderr, "kernel_launch: unexpected shapes (n_in %d, in0 %d, out %d, ws %zu); nothing launched\n", n_in, n_in > 0 ? in_sizes[0] : -1, out_size, ws_size); grid = -1; return; }
        int dev = 0, cus = 0, per_cu = 0;
        if (hipGetDevice(&dev) != hipSuccess || hipDeviceGetAttribute(&cus, hipDeviceAttributeMultiprocessorCount, dev) != hipSuccess) { grid = -1; return; }
        bool ok = setup_kernel<0x7FFu>(per_cu);
        if (!ok) { fprintf(stderr, "kernel_launch: hipFuncSetAttribute failed\n"); grid = -1; return; }
        grid = cus;
    }
    if (grid < 0) return;
    if (hipMemsetAsync((char*)d_ws + WS_CTL, 0, CTL_ZERO_BYTES, stream) != hipSuccess) return;
    Args a{};
    for (int i = 0; i < 18; ++i) a.in[i] = (const float*)d_in[i];
    a.out = (float*)d_out; a.ws = (unsigned char*)d_ws;
    a.ph_lo = 0; a.ph_hi = N_PHASES;
    hipLaunchKernelGGL(fwd<0x7FFu>, dim3(grid), dim3(NWAVES * 64), LDS_BYTES, stream, a);
}
```

```cpp
#include <hip/hip_runtime.h>
#include <cstdio>
#include <cstdint>
__device__ __forceinline__ int lane_id_v() { int l; asm volatile("v_mbcnt_lo_u32_b32 %0, -1, 0\n\tv_mbcnt_hi_u32_b32 %0, -1, %0" : "=v"(l)); return l; }
namespace pg8 {
#define PG8_LAS __attribute__((address_space(3)))
typedef unsigned short bf16_t;
typedef short bf16x8 __attribute__((ext_vector_type(8)));
typedef float f32x4 __attribute__((ext_vector_type(4)));
typedef unsigned u32x4 __attribute__((ext_vector_type(4)));
constexpr int BM = 256, BK = 64, HALF = 128, HTB = HALF * BK * 2  , STAGE_BYTES = 8 * HTB, NXCD = 8, WGM = 8;

__host__ __device__ __forceinline__ int lds_byte(int r, int c) { const int st = (r >> 4) * 2 + (c >> 5), rr = r & 15, cc = c & 31, ob = rr * 64 + cc * 2; return st * 1024 + (ob ^ (((ob >> 9) & 1) << 5)); }
__host__ __device__ __forceinline__ void stage_rc(int b, int& R, int& C) { const int st = b / 1024, sb = b % 1024, swz = sb ^ (((sb >> 9) & 1) << 5); R = (st >> 1) * 16 + swz / 64; C = (st & 1) * 32 + (swz % 64) / 2; }
__host__ __device__ __forceinline__ int perm32(int rho) { const int n = rho >> 4, i = rho & 15; return 8 * (i >> 2) + 4 * n + (i & 3); }

struct Unit { int pm, pn, li; };
struct Gemm { const bf16_t* A; const bf16_t* Bt; int M, N, K; int ld; };

struct StaticOrder {
    int nM, nN, nwg, G, c;
    __host__ __device__ void init(int M, int N, int G_, int c_) { nM = M / BM; nN = N / BM; nwg = nM * nN; G = G_; c = c_; }
    __host__ __device__ bool next(int i, Unit& u) const {
        const long L = (long)i * G + c; if (L >= nwg) return false;
        int wgid = (int)L; { const int q = nwg / NXCD, r = nwg % NXCD, xcd = wgid % NXCD, off = wgid / NXCD; wgid = (xcd < r ? xcd * (q + 1) : r * (q + 1) + (xcd - r) * q) + off; }
        const int nig = WGM * nN, gid = wgid / nig, fm = gid * WGM, gsz = (nM - fm) < WGM ? (nM - fm) : WGM;
        u.pm = fm + ((wgid % nig) % gsz); u.pn = (wgid % nig) / gsz; return true;
    }
    __device__ __forceinline__ void a_ready(const Unit&) const {}
    __device__ __forceinline__ void done(const Unit&) const {}
};

__device__ __forceinline__ unsigned cvt_pk_bf16(float lo, float hi) { unsigned r; asm volatile("v_cvt_pk_bf16_f32 %0, %1, %2" : "=v"(r) : "v"(lo), "v"(hi)); return r; }
typedef float f32x2 __attribute__((ext_vector_type(2)));
struct EpiBf16S {
    static constexpr bool PERM = true, AFTER_DRAIN = false; static constexpr bool LINE = true;
    bf16_t* O; int ldc; int split_cols; size_t split_stride;
    __device__ __forceinline__ void operator()(const f32x4 (&acc)[2][2][4][2], const Unit& u, int wr, int wc, int fr, int fq) const {
        const bool lo = fr < 8;
        const int row0 = u.pm * BM + wr * 64 + (fr & 7); int colt = u.pn * BM; bf16_t* base = O;
        if (split_cols) { const int t = colt / split_cols; base += (size_t)t * split_stride; colt -= t * split_cols; }
        const int col0 = colt + wc * 64 + (fr >> 3) * 32 + 8 * fq;
#pragma unroll
        for (int ai = 0; ai < 2; ++ai)
#pragma unroll
            for (int m = 0; m < 4; ++m) { bf16_t* rowp = base + (size_t)(row0 + ai * HALF + m * 16) * ldc + col0;
                u32x4 w0, w1, A, B;
                { const f32x4 v0 = acc[ai][0][m][0], v1 = acc[ai][0][m][1]; w0.x = cvt_pk_bf16(v0[0], v0[1]); w0.y = cvt_pk_bf16(v0[2], v0[3]); w0.z = cvt_pk_bf16(v1[0], v1[1]); w0.w = cvt_pk_bf16(v1[2], v1[3]); }
                { const f32x4 v0 = acc[ai][1][m][0], v1 = acc[ai][1][m][1]; w1.x = cvt_pk_bf16(v0[0], v0[1]); w1.y = cvt_pk_bf16(v0[2], v0[3]); w1.z = cvt_pk_bf16(v1[0], v1[1]); w1.w = cvt_pk_bf16(v1[2], v1[3]); }
#pragma unroll
                for (int j = 0; j < 4; ++j) { const unsigned give = lo ? w1[j] : w0[j];
                    const unsigned recv = (unsigned)__builtin_amdgcn_update_dpp(0, (int)give, 0x128  , 0xf, 0xf, false);
                    A[j] = lo ? w0[j] : recv; B[j] = lo ? recv : w1[j]; }
                *(u32x4*)rowp = A; *(u32x4*)(rowp + (size_t)8 * ldc) = B; }
    }
};
struct EpiResF32 {
    static constexpr bool PERM = false, AFTER_DRAIN = false; static constexpr bool LINE = false;
    const float* base; float* C; int ldc;
    __device__ __forceinline__ void operator()(const f32x4 (&acc)[2][2][4][2], const Unit& u, int wr, int wc, int fr, int fq) const {
        const int row0 = u.pm * BM + wr * 64 + fr, col0 = u.pn * BM + wc * 32 + 4 * fq;
#pragma unroll
        for (int ai = 0; ai < 2; ++ai) { constexpr int m0 = 0;
            f32x4 bv[4][2][2];
#pragma unroll
            for (int m = m0; m < m0 + 4; ++m) { const size_t off = (size_t)(row0 + ai * HALF + m * 16) * ldc + col0;
#pragma unroll
                for (int bj = 0; bj < 2; ++bj)
#pragma unroll
                    for (int n = 0; n < 2; ++n) bv[m][bj][n] = *(const f32x4*)(base + off + bj * HALF + n * 16); }
#pragma unroll
            for (int m = m0; m < m0 + 4; ++m) { const size_t off = (size_t)(row0 + ai * HALF + m * 16) * ldc + col0;
#pragma unroll
                for (int bj = 0; bj < 2; ++bj)
#pragma unroll
                    for (int n = 0; n < 2; ++n) *(f32x4*)(C + off + bj * HALF + n * 16) = bv[m][bj][n] + acc[ai][bj][m][n]; }
        }
    }
};
__device__ __forceinline__ float silu_f(float x) { return x * __builtin_amdgcn_rcpf(1.0f + __expf(-x)); }
struct EpiSwiGLU {
    static constexpr bool PERM = true, AFTER_DRAIN = false; static constexpr bool LINE = false;
    bf16_t* H; const PG8_LAS float* rowsc;
    __device__ __forceinline__ void operator()(const f32x4 (&acc)[2][2][4][2], const Unit& u, int wr, int wc, int fr, int fq) const {
        const int row0 = u.pm * BM + wr * 64 + fr, col0 = (u.pn & 3) * 128 + wc * 32 + 8 * fq;
        float scv[2][4];
#pragma unroll
        for (int ai = 0; ai < 2; ++ai)
#pragma unroll
            for (int m = 0; m < 4; ++m) scv[ai][m] = rowsc[u.li * BM + wr * 64 + fr + ai * HALF + m * 16];
#pragma unroll
        for (int ai = 0; ai < 2; ++ai)
#pragma unroll
            for (int m = 0; m < 4; ++m) { bf16_t* rowp = H + (size_t)(row0 + ai * HALF + m * 16) * 512 + col0; const float sc = scv[ai][m];
                const f32x4 g0 = acc[ai][0][m][0] * sc, g1 = acc[ai][0][m][1] * sc, u0 = acc[ai][1][m][0] * sc, u1 = acc[ai][1][m][1] * sc;
                f32x4 h0, h1;
#pragma unroll
                for (int j = 0; j < 4; ++j) { h0[j] = silu_f(g0[j]) * u0[j]; h1[j] = silu_f(g1[j]) * u1[j]; }
                u32x4 w; w.x = cvt_pk_bf16(h0[0], h0[1]); w.y = cvt_pk_bf16(h0[2], h0[3]); w.z = cvt_pk_bf16(h1[0], h1[1]); w.w = cvt_pk_bf16(h1[2], h1[3]);
                *(u32x4*)rowp = w; }
    }
};
struct EpiDown {
    static constexpr bool PERM = true, AFTER_DRAIN = false; static constexpr bool LINE = true;
    bf16_t* Y; const PG8_LAS float* rowgate;
    __device__ __forceinline__ void operator()(const f32x4 (&acc)[2][2][4][2], const Unit& u, int wr, int wc, int fr, int fq) const {
        const bool lo = fr < 8;
        const int row0 = u.pm * BM + wr * 64 + (fr & 7), col0 = (u.pn & 7) * 256 + wc * 64 + (fr >> 3) * 32 + 8 * fq;
        float gtv[2][4];
#pragma unroll
        for (int ai = 0; ai < 2; ++ai)
#pragma unroll
            for (int m = 0; m < 4; ++m) gtv[ai][m] = rowgate[u.li * BM + wr * 64 + fr + ai * HALF + m * 16];
#pragma unroll
        for (int ai = 0; ai < 2; ++ai)
#pragma unroll
            for (int m = 0; m < 4; ++m) { const float gt = gtv[ai][m]; bf16_t* rowp = Y + (size_t)(row0 + ai * HALF + m * 16) * 2048 + col0;
                u32x4 w0, w1, A, B;
                { const f32x4 v0 = acc[ai][0][m][0] * gt, v1 = acc[ai][0][m][1] * gt; w0.x = cvt_pk_bf16(v0[0], v0[1]); w0.y = cvt_pk_bf16(v0[2], v0[3]); w0.z = cvt_pk_bf16(v1[0], v1[1]); w0.w = cvt_pk_bf16(v1[2], v1[3]); }
                { const f32x4 v0 = acc[ai][1][m][0] * gt, v1 = acc[ai][1][m][1] * gt; w1.x = cvt_pk_bf16(v0[0], v0[1]); w1.y = cvt_pk_bf16(v0[2], v0[3]); w1.z = cvt_pk_bf16(v1[0], v1[1]); w1.w = cvt_pk_bf16(v1[2], v1[3]); }
#pragma unroll
                for (int j = 0; j < 4; ++j) { const unsigned give = lo ? w1[j] : w0[j];
                    const unsigned recv = (unsigned)__builtin_amdgcn_update_dpp(0, (int)give, 0x128  , 0xf, 0xf, false);
                    A[j] = lo ? w0[j] : recv; B[j] = lo ? recv : w1[j]; }
                *(u32x4*)rowp = A; *(u32x4*)(rowp + (size_t)8 * 2048) = B; }
    }
};
struct EpiResB16 {
    static constexpr bool PERM = true, AFTER_DRAIN = false; static constexpr bool LINE = false;
    const float* base; bf16_t* C; int ldc;
    __device__ __forceinline__ void operator()(const f32x4 (&acc)[2][2][4][2], const Unit& u, int wr, int wc, int fr, int fq) const {
        const int row0 = u.pm * BM + wr * 64 + fr, col0 = u.pn * BM + wc * 32 + 8 * fq;
#pragma unroll
        for (int ai = 0; ai < 2; ++ai) {
            f32x4 bv[4][2][2];
#pragma unroll
            for (int m = 0; m < 4; ++m) { const size_t off = (size_t)(row0 + ai * HALF + m * 16) * ldc + col0;
#pragma unroll
                for (int bj = 0; bj < 2; ++bj)
#pragma unroll
                    for (int n = 0; n < 2; ++n) bv[m][bj][n] = *(const f32x4*)(base + off + bj * HALF + n * 4); }
#pragma unroll
            for (int m = 0; m < 4; ++m) { const size_t off = (size_t)(row0 + ai * HALF + m * 16) * ldc + col0;
#pragma unroll
                for (int bj = 0; bj < 2; ++bj) { const f32x4 v0 = bv[m][bj][0] + acc[ai][bj][m][0], v1 = bv[m][bj][1] + acc[ai][bj][m][1];
                    u32x4 w; w.x = cvt_pk_bf16(v0[0], v0[1]); w.y = cvt_pk_bf16(v0[2], v0[3]); w.z = cvt_pk_bf16(v1[0], v1[1]); w.w = cvt_pk_bf16(v1[2], v1[3]);
                    *(u32x4*)(C + off + bj * HALF) = w; } }
        }
    }
};
struct EpiRes2 {
    static constexpr bool PERM = true, AFTER_DRAIN = false; static constexpr bool LINE = false;
    const bf16_t* base; bf16_t* Hb; float* ssq; int ldc;
    __device__ __forceinline__ void operator()(const f32x4 (&acc)[2][2][4][2], const Unit& u, int wr, int wc, int fr, int fq) const {
        const int row0 = u.pm * BM + wr * 64 + fr, col0 = u.pn * BM + wc * 32 + 8 * fq;
#pragma unroll
        for (int ai = 0; ai < 2; ++ai) {
            u32x4 bb[4][2];
#pragma unroll
            for (int m = 0; m < 4; ++m) { const size_t off = (size_t)(row0 + ai * HALF + m * 16) * ldc + col0;
#pragma unroll
                for (int bj = 0; bj < 2; ++bj) bb[m][bj] = *(const u32x4*)(base + off + bj * HALF); }
#pragma unroll
            for (int m = 0; m < 4; ++m) { const int row = row0 + ai * HALF + m * 16; const size_t off = (size_t)row * ldc + col0; float s = 0.f;
#pragma unroll
                for (int bj = 0; bj < 2; ++bj) { const u32x4 b = bb[m][bj]; f32x4 h0 = acc[ai][bj][m][0], h1 = acc[ai][bj][m][1];
                    h0[0] += __uint_as_float(b.x << 16); h0[1] += __uint_as_float(b.x & 0xffff0000u); h0[2] += __uint_as_float(b.y << 16); h0[3] += __uint_as_float(b.y & 0xffff0000u);
                    h1[0] += __uint_as_float(b.z << 16); h1[1] += __uint_as_float(b.z & 0xffff0000u); h1[2] += __uint_as_float(b.w << 16); h1[3] += __uint_as_float(b.w & 0xffff0000u);
                    s += ((h0[0] * h0[0] + h0[1] * h0[1]) + (h0[2] * h0[2] + h0[3] * h0[3])) + ((h1[0] * h1[0] + h1[1] * h1[1]) + (h1[2] * h1[2] + h1[3] * h1[3]));
                    u32x4 w; w.x = cvt_pk_bf16(h0[0], h0[1]); w.y = cvt_pk_bf16(h0[2], h0[3]); w.z = cvt_pk_bf16(h1[0], h1[1]); w.w = cvt_pk_bf16(h1[2], h1[3]);
                    *(u32x4*)(Hb + off + bj * HALF) = w; }
                s += __shfl_xor(s, 16); s += __shfl_xor(s, 32);
                if (fq == 0) ssq[(size_t)row * 32 + u.pn * 4 + wc] = s; }
        }
    }
};
struct EpiRouter {
    static constexpr bool PERM = false, AFTER_DRAIN = true; static constexpr bool LINE = false;
    const float* ssq; const float* rgb; const float* reb; int* eid; float* gate; float* rstd_out; int* cnt;
    __device__ __forceinline__ void fused(f32x4 (&acc)[2][2][4][2], const Unit& u, int wr, int wc, int fr, int fq, PG8_LAS unsigned char* lds, int wid, int lane) const {
        PG8_LAS float* LG = (PG8_LAS float*)lds;
        PG8_LAS int* hc = (PG8_LAS int*)(lds + 256 * 76 * 4);
        if (wid == 0) hc[lane] = 0;
        if (wc < 3) {
#pragma unroll
            for (int ai = 0; ai < 2; ++ai)
#pragma unroll
                for (int m = 0; m < 4; ++m) { const int row = ai * HALF + wr * 64 + m * 16 + fr;
#pragma unroll
                    for (int n = 0; n < 2; ++n) { const int c0 = 32 * wc + 16 * n + 4 * fq; if (c0 < 72) *(PG8_LAS f32x4*)(LG + row * 76 + c0) = acc[ai][0][m][n]; } }
        }
        asm volatile("s_waitcnt lgkmcnt(0)" ::: "memory"); __builtin_amdgcn_s_barrier(); asm volatile("" ::: "memory");
        int mycnt = 0;
        float rsl;
        { const f32x4* sp = (const f32x4*)(ssq + (size_t)(u.pm * BM + wid * 32 + (lane & 31)) * 32); f32x4 a = sp[0];
#pragma unroll
          for (int q = 1; q < 8; ++q) a += sp[q];
          rsl = rsqrtf(((a.x + a.y) + (a.z + a.w)) * (1.f / 2048.f) + 1e-6f); }
#pragma unroll 1
        for (int rr = 0; rr < 32; ++rr) {
            const int row = wid * 32 + rr, t = u.pm * BM + row;
            const float rs = __shfl(rsl, rr);
            const float gl = LG[row * 76 + (lane & 7)] * rs + rgb[lane & 7], el = LG[row * 76 + 8 + lane] * rs + reb[lane];
            float gm = gl; gm = fmaxf(gm, __shfl_xor(gm, 1)); gm = fmaxf(gm, __shfl_xor(gm, 2)); gm = fmaxf(gm, __shfl_xor(gm, 4));
            int gi = (gl == gm) ? (lane & 7) : 8; gi = min(gi, __shfl_xor(gi, 1)); gi = min(gi, __shfl_xor(gi, 2)); gi = min(gi, __shfl_xor(gi, 4));
            float gsum = __expf(gl - gm); gsum += __shfl_xor(gsum, 1); gsum += __shfl_xor(gsum, 2); gsum += __shfl_xor(gsum, 4);
            gi = __builtin_amdgcn_readfirstlane(gi); const float gwt = 1.0f / gsum;
            const float v = __shfl(el, gi * 8 + (lane & 7));
            float m1 = v; m1 = fmaxf(m1, __shfl_xor(m1, 1)); m1 = fmaxf(m1, __shfl_xor(m1, 2)); m1 = fmaxf(m1, __shfl_xor(m1, 4));
            int i1 = (v == m1) ? (lane & 7) : 8; i1 = min(i1, __shfl_xor(i1, 1)); i1 = min(i1, __shfl_xor(i1, 2)); i1 = min(i1, __shfl_xor(i1, 4));
            const float v2 = ((lane & 7) == i1) ? -3.0e38f : v;
            float m2 = v2; m2 = fmaxf(m2, __shfl_xor(m2, 1)); m2 = fmaxf(m2, __shfl_xor(m2, 2)); m2 = fmaxf(m2, __shfl_xor(m2, 4));
            int i2 = (v2 == m2) ? (lane & 7) : 8; i2 = min(i2, __shfl_xor(i2, 1)); i2 = min(i2, __shfl_xor(i2, 2)); i2 = min(i2, __shfl_xor(i2, 4));
            const float e2 = __expf(m2 - m1), inv = 1.0f / (1.0f + e2);
            const int e_a = gi * 8 + __builtin_amdgcn_readfirstlane(i1), e_b = gi * 8 + __builtin_amdgcn_readfirstlane(i2);
            mycnt += (lane == e_a) + (lane == e_b);
            if (lane == 0) { eid[t * 2] = e_a; eid[t * 2 + 1] = e_b; gate[t * 2] = gwt * inv; gate[t * 2 + 1] = gwt * e2 * inv; rstd_out[t] = rs; }
        }
        atomicAdd((int*)&hc[lane], mycnt);
        asm volatile("s_waitcnt lgkmcnt(0)" ::: "memory"); __builtin_amdgcn_s_barrier(); asm volatile("" ::: "memory");
        if (wid == 0) cnt[u.pm * 64 + lane] = hc[lane];
    }
};
struct MoeOrder {
    const PG8_LAS int* tile_e; int ntiles, NT, G, c, skip_e, skip_tiles;
    __device__ __forceinline__ bool next(int i, Unit& u) const {
        int r, nt;
        if ((G & 7) == 0) { const int x = c & 7, rank = c >> 3, W = G >> 3; const int t0 = (int)((long)ntiles * x / 8), t1 = (int)((long)ntiles * (x + 1) / 8);
            const int j = i * W + rank; if (j >= (t1 - t0) * NT) return false; r = t0 + j / NT; nt = j % NT; }
        else { const long L = (long)i * G + c; if (L >= (long)ntiles * NT) return false; r = (int)(L / NT); nt = (int)(L % NT); }
        const int e = __builtin_amdgcn_readfirstlane(tile_e[r]); u.pm = r; u.pn = e * NT + nt + (e >= skip_e ? skip_tiles : 0); u.li = i; return true;
    }
    __device__ __forceinline__ void a_ready(const Unit&) const {}
    __device__ __forceinline__ void done(const Unit&) const {}
};
template <class Epi, class Sched, bool ALIGN_EPI = false, bool SP2 = false, bool GATHER = false>
__device__ __forceinline__ void gemm_phase(PG8_LAS unsigned char* lds, const Gemm g, const Sched& S, const Epi& E, const int wid, const PG8_LAS int* rowidx = nullptr) {
    const int lane = lane_id_v(), tid = wid * 64 + lane, wr = wid >> 2, wc = wid & 3, fr = lane & 15, fq = lane >> 4;
    const int K = g.K, nt = K / BK, LD = g.ld ? g.ld : g.K;
    unsigned voffA[2], voffB[2];
#pragma unroll
    for (int i = 0; i < 2; ++i) { int R, C; stage_rc(tid * 16 + i * 8192, R, C); const int Rb = Epi::PERM ? ((Epi::LINE ? 2 : 1) * (R & ~31) + perm32(R & 31)) : R;
        voffA[i] = (unsigned)(R * LD + C) * 2u; voffB[i] = (unsigned)(Rb * LD + C) * 2u; }
    int gR[2], gC[2];
#pragma unroll
    for (int i = 0; i < 2; ++i) stage_rc(tid * 16 + i * 8192, gR[i], gC[i]);
    unsigned offC[2][2], offN[2][2];
    const size_t kstep = (size_t)(BK * 2);
    const size_t hstep = (size_t)HALF * LD * 2; const size_t hstepA = GATHER ? 0 : hstep;
    const size_t hstepB = Epi::LINE ? (size_t)32 * LD * 2 : hstep;
    const size_t tstep = 2 * hstep;
    const unsigned ldsw = (unsigned)wid * 1024u;
    const int aoff = lds_byte(wr * 64 + fr, fq * 8), boff = lds_byte(wc * 32 + fr, fq * 8);
#define PG8_SA(b, h) (((b) * 2 + (h)) * HTB)
#define PG8_SB(b, h) ((4 + (b) * 2 + (h)) * HTB)
#define PG8_STAGE(bufoff, gbase, voff) do { _Pragma("unroll") for (int _i = 0; _i < 2; ++_i) \
        __builtin_amdgcn_global_load_lds((const unsigned*)((const char*)(gbase) + (voff)[_i]), (PG8_LAS unsigned*)(lds + (bufoff) + ldsw + _i * 8192), 16, 0, 0); } while (0)
#define PG8_LDA(dst, b, h) do { _Pragma("unroll") for (int m = 0; m < 4; ++m) _Pragma("unroll") for (int k = 0; k < 2; ++k) dst[m][k] = *(const PG8_LAS bf16x8*)(lds + PG8_SA(b, h) + aoff + m * 2048 + k * 1024); } while (0)
#define PG8_LDB(dst, b, h) do { _Pragma("unroll") for (int n = 0; n < 2; ++n) _Pragma("unroll") for (int k = 0; k < 2; ++k) dst[n][k] = *(const PG8_LAS bf16x8*)(lds + PG8_SB(b, h) + boff + n * 2048 + k * 1024); } while (0)
#define PG8_MMA(ai, bj, At, Bt) do { __builtin_amdgcn_s_setprio(1); _Pragma("unroll") for (int m = 0; m < 4; ++m) _Pragma("unroll") for (int n = 0; n < 2; ++n) _Pragma("unroll") for (int k = 0; k < 2; ++k) \
        acc[ai][bj][m][n] = __builtin_amdgcn_mfma_f32_16x16x32_bf16(Bt[n][k], At[m][k], acc[ai][bj][m][n], 0, 0, 0); __builtin_amdgcn_s_setprio(0); } while (0)
#define PG8_WAIT_V(n) asm volatile("s_waitcnt vmcnt(" #n ")" ::: "memory")
#define PG8_WAIT_L(n) asm volatile("s_waitcnt lgkmcnt(" #n ")" ::: "memory")
#define PG8_BAR __builtin_amdgcn_s_barrier()
#define PG8_SCHED __builtin_amdgcn_sched_barrier(0)
    Unit cur, nxt; int ui = 0;
    if (!S.next(0, cur)) return;
    f32x4 acc[2][2][4][2];
#pragma unroll
    for (int a = 0; a < 2; ++a)
#pragma unroll
        for (int b = 0; b < 2; ++b)
#pragma unroll
            for (int m = 0; m < 4; ++m)
#pragma unroll
                for (int n = 0; n < 2; ++n) acc[a][b][m][n] = (f32x4){0.f, 0.f, 0.f, 0.f};
    bf16x8 At[4][2], B0[2][2], B1[2][2];
    const char* cA = GATHER ? (const char*)g.A : (const char*)g.A + (size_t)cur.pm * tstep; const char* cB = (const char*)g.Bt + (size_t)cur.pn * tstep;
#pragma unroll
    for (int h = 0; h < 2; ++h)
#pragma unroll
        for (int i = 0; i < 2; ++i) { offC[h][i] = GATHER ? (unsigned)rowidx[h * HALF + gR[i]] * (unsigned)(LD * 2) + (unsigned)(gC[i] * 2) : voffA[i]; offN[h][i] = offC[h][i]; }
    S.a_ready(cur);
    if constexpr (SP2) {
        PG8_STAGE(PG8_SB(0, 0), cB, voffB); PG8_STAGE(PG8_SB(0, 1), cB + hstepB, voffB); PG8_STAGE(PG8_SA(0, 0), cA, offC[0]); PG8_STAGE(PG8_SA(0, 1), cA + hstepA, offC[1]);
        if (wr == 1) PG8_BAR;
        PG8_WAIT_V(2); PG8_BAR;
        PG8_STAGE(PG8_SB(1, 0), cB + kstep, voffB); PG8_STAGE(PG8_SA(1, 0), cA + kstep, offC[0]); PG8_STAGE(PG8_SB(1, 1), cB + hstepB + kstep, voffB);
        PG8_WAIT_V(6); PG8_BAR;
    } else {
        PG8_STAGE(PG8_SB(0, 0), cB, voffB); PG8_STAGE(PG8_SA(0, 0), cA, offC[0]); PG8_STAGE(PG8_SB(0, 1), cB + hstepB, voffB); PG8_STAGE(PG8_SA(0, 1), cA + hstepA, offC[1]);
        if (wr == 1) PG8_BAR;
        PG8_WAIT_V(4); PG8_BAR;
        PG8_STAGE(PG8_SB(1, 0), cB + kstep, voffB); PG8_STAGE(PG8_SA(1, 0), cA + kstep, offC[0]); PG8_STAGE(PG8_SB(1, 1), cB + hstepB + kstep, voffB);
        PG8_WAIT_V(6); PG8_BAR;
    }
    for (;;) {
        const bool has_next = S.next(ui + 1, nxt);
        const char* nA = (has_next && !GATHER) ? (const char*)g.A + (size_t)nxt.pm * tstep : cA;
        if (GATHER && has_next) {
#pragma unroll
            for (int h = 0; h < 2; ++h)
#pragma unroll
                for (int i = 0; i < 2; ++i) offN[h][i] = (unsigned)rowidx[(ui + 1) * BM + h * HALF + gR[i]] * (unsigned)(LD * 2) + (unsigned)(gC[i] * 2);
        } const char* nB = has_next ? (const char*)g.Bt + (size_t)nxt.pn * tstep : cB;
        for (int t = 0; t < nt; t += 2) {
            const bool last = (t == nt - 2);
            const char* a1 = cA + (size_t)(t + 1) * kstep;
            const char* a2 = last ? nA : cA + (size_t)(t + 2) * kstep; const char* b2 = last ? nB : cB + (size_t)(t + 2) * kstep;
            const char* a3 = a2 + kstep; const char* b3 = b2 + kstep;
            unsigned o2[2][2];
#pragma unroll
            for (int h = 0; h < 2; ++h)
#pragma unroll
                for (int i = 0; i < 2; ++i) o2[h][i] = last ? offN[h][i] : offC[h][i];
            if (last && has_next) S.a_ready(nxt);
            if constexpr (SP2) {
            PG8_LDB(B0, 0, 0); PG8_LDB(B1, 0, 1); PG8_SCHED; PG8_LDA(At, 0, 0); PG8_STAGE(PG8_SA(1, 1), a1 + hstepA, offC[1]);
            PG8_WAIT_V(8); PG8_WAIT_L(0); PG8_BAR; PG8_MMA(0, 0, At, B0); PG8_MMA(0, 1, At, B1); PG8_BAR; PG8_SCHED;
            PG8_LDA(At, 0, 1); PG8_STAGE(PG8_SB(0, 0), b2, voffB); PG8_STAGE(PG8_SB(0, 1), b2 + hstepB, voffB); PG8_STAGE(PG8_SA(0, 0), a2, o2[0]);
            PG8_WAIT_V(8); PG8_WAIT_L(0); PG8_BAR; PG8_MMA(1, 0, At, B0); PG8_MMA(1, 1, At, B1); PG8_BAR; PG8_SCHED;
            PG8_LDB(B0, 1, 0); PG8_LDB(B1, 1, 1); PG8_SCHED; PG8_LDA(At, 1, 0); PG8_STAGE(PG8_SA(0, 1), a2 + hstepA, o2[1]);
            PG8_WAIT_V(8); PG8_WAIT_L(0); PG8_BAR; PG8_MMA(0, 0, At, B0); PG8_MMA(0, 1, At, B1); PG8_BAR; PG8_SCHED;
            PG8_LDA(At, 1, 1); PG8_STAGE(PG8_SB(1, 0), b3, voffB); PG8_STAGE(PG8_SB(1, 1), b3 + hstepB, voffB); PG8_STAGE(PG8_SA(1, 0), a3, o2[0]);
            PG8_WAIT_V(8); PG8_WAIT_L(0); PG8_BAR; PG8_MMA(1, 0, At, B0); PG8_MMA(1, 1, At, B1); PG8_BAR; PG8_SCHED;
            } else {
            PG8_LDB(B0, 0, 0); PG8_SCHED; PG8_LDA(At, 0, 0); PG8_STAGE(PG8_SA(1, 1), a1 + hstepA, offC[1]);
            PG8_WAIT_L(8); PG8_BAR; PG8_WAIT_L(0); PG8_MMA(0, 0, At, B0); PG8_BAR; PG8_SCHED;
            PG8_LDB(B1, 0, 1); PG8_STAGE(PG8_SB(0, 0), b2, voffB);
            PG8_BAR; PG8_WAIT_L(0); PG8_MMA(0, 1, At, B1); PG8_BAR;
            PG8_LDA(At, 0, 1); PG8_STAGE(PG8_SA(0, 0), a2, o2[0]);
            PG8_BAR; PG8_WAIT_L(0); PG8_MMA(1, 0, At, B0); PG8_BAR; PG8_SCHED;
            PG8_STAGE(PG8_SB(0, 1), b2 + hstepB, voffB);
            PG8_WAIT_V(6); PG8_BAR; PG8_MMA(1, 1, At, B1); PG8_BAR;
            PG8_LDB(B0, 1, 0); PG8_SCHED; PG8_LDA(At, 1, 0); PG8_STAGE(PG8_SA(0, 1), a2 + hstepA, o2[1]);
            PG8_WAIT_L(8); PG8_BAR; PG8_WAIT_L(0); PG8_MMA(0, 0, At, B0); PG8_BAR; PG8_SCHED;
            PG8_LDB(B1, 1, 1); PG8_STAGE(PG8_SB(1, 0), b3, voffB);
            PG8_BAR; PG8_WAIT_L(0); PG8_MMA(0, 1, At, B1); PG8_BAR;
            PG8_LDA(At, 1, 1); PG8_STAGE(PG8_SA(1, 0), a3, o2[0]);
            PG8_BAR; PG8_WAIT_L(0); PG8_MMA(1, 0, At, B0); PG8_BAR; PG8_SCHED;
            PG8_STAGE(PG8_SB(1, 1), b3 + hstepB, voffB);
            PG8_WAIT_V(6); PG8_BAR; PG8_MMA(1, 1, At, B1); PG8_BAR;
            }
        }
        if constexpr (ALIGN_EPI) { if (wr == 0) PG8_BAR; }
        if constexpr (!Epi::AFTER_DRAIN) { E(acc, cur, wr, wc, fr, fq); S.done(cur); }
        if (!has_next) break;
#pragma unroll
        for (int a = 0; a < 2; ++a)
#pragma unroll
            for (int b = 0; b < 2; ++b)
#pragma unroll
                for (int m = 0; m < 4; ++m)
#pragma unroll
                    for (int n = 0; n < 2; ++n) acc[a][b][m][n] = (f32x4){0.f, 0.f, 0.f, 0.f};
        cur = nxt; cA = nA; cB = nB; ++ui;
#pragma unroll
        for (int h = 0; h < 2; ++h)
#pragma unroll
            for (int i = 0; i < 2; ++i) offC[h][i] = offN[h][i];
        if constexpr (ALIGN_EPI) { if (wr == 1) PG8_BAR; }
    }
    PG8_WAIT_V(0);
    if constexpr (!ALIGN_EPI) { if (wr == 0) PG8_BAR; }
    PG8_BAR;
    if constexpr (Epi::AFTER_DRAIN) { E.fused(acc, cur, wr, wc, fr, fq, lds, wid, lane); S.done(cur); }
#undef PG8_SA
#undef PG8_SB
#undef PG8_STAGE
#undef PG8_LDA
#undef PG8_LDB
#undef PG8_MMA
#undef PG8_WAIT_V
#undef PG8_WAIT_L
#undef PG8_BAR
#undef PG8_SCHED
}
}
#ifndef PG8_SP2
#define PG8_SP2 true
#endif
#ifndef PG8_ALIGN
#define PG8_ALIGN true
#endif
constexpr int NWAVES = 8;
constexpr int BATCH = 2, SEQ = 16384, T = BATCH * SEQ, D = 2048;
constexpr int NH = 8, HD = 128, GW = 1024, SCW = 1024;
constexpr int IN_COLS = 7184, NPROJ = 7168;
constexpr int NE = 64, DE = 512, CAP_ROWS = 65536 + 64 * 256, MAX_TILES = CAP_ROWS / 256;
constexpr float EPS = 1e-6f;
constexpr int N_PHASES = 11;
constexpr int NSCAN = 2 * BATCH * NH;
constexpr int GDN_SPLIT = 128;

constexpr size_t MiB = 1u << 20;
constexpr size_t WS_CTL = 0, CTL_ZERO_BYTES = 1 * MiB;
constexpr size_t WS_BA = 1 * MiB;
constexpr size_t WS_GB = 3 * MiB;
constexpr size_t WS_RSTD = 5 * MiB;
constexpr size_t WS_EID = 6 * MiB;
constexpr size_t WS_GATE = 7 * MiB;
constexpr size_t WS_POS = 8 * MiB;
constexpr size_t WS_ROWTOK = 9 * MiB;
constexpr size_t WS_ROWGATE = 10 * MiB;
constexpr size_t WS_TILES = 11 * MiB;
constexpr size_t WS_ROWSC = 11 * MiB + 512 * 1024;
constexpr size_t WS_DSC = 12 * MiB;
constexpr size_t WS_SBUF = 15 * MiB;
constexpr size_t WS_CNT = 13 * MiB;
constexpr size_t WS_WR = 14 * MiB;
constexpr size_t WS_SSQ = 940 * MiB;
constexpr size_t WS_WIN = 16 * MiB;
constexpr size_t WS_WOUT = 44 * MiB;
constexpr size_t WS_R0 = 52 * MiB;
constexpr size_t WS_R1 = 180 * MiB;
constexpr size_t WS_R3 = 628 * MiB;
constexpr size_t WS_H1B = 948 * MiB;
constexpr size_t WS_END = 1076 * MiB;
constexpr size_t GI_NW = 0, GI_QD = 16384, GI_AT = 32768, GI_KD = 40960, GI_DMA = 57344, GI_U = 57344, GI_UNIT = 73728;
constexpr size_t PROJ_T = (size_t)T * 1024;
constexpr size_t WGU_ELEMS = (size_t)NE * 1024 * 2048;

constexpr int RING_OFF = 0, RING_BYTES = 131072;
constexpr int LDS_BYTES = 151552;
constexpr int LDSCTL_OFF = LDS_BYTES - 256, MISC_OFF = LDSCTL_OFF;
constexpr int P2_KN = 0, P2_QN = 17408, P2_XT = 0  , P2_KT = 34816, P2_VT = 53248, P2_AM = 71680, P2_AT = 89088, P2_TU = 98304, P2_TW = 107520, P2_SM = 116736, P2_CW = 120832;
constexpr int P3_UB = 114688, P3_OB = 131072, P3_DL = 148480, P3_NW = 149504;
static_assert(P3_NW + 512 <= LDSCTL_OFF, "LDS map");

#define GAS __attribute__((address_space(1)))
#define LAS __attribute__((address_space(3)))
typedef unsigned short bf16;
typedef unsigned v4u __attribute__((ext_vector_type(4)));
typedef unsigned v2u __attribute__((ext_vector_type(2)));
typedef float f32x4 __attribute__((ext_vector_type(4)));
typedef GAS unsigned gu32;
typedef float f32x16 __attribute__((ext_vector_type(16)));
typedef short bf16x8 __attribute__((ext_vector_type(8)));
typedef __bf16 bf16x2_t __attribute__((ext_vector_type(2)));
typedef float f32x2_t __attribute__((ext_vector_type(2)));
__device__ __forceinline__ unsigned cvtpk(float lo, float hi) { f32x2_t v = {lo, hi}; bf16x2_t b = __builtin_convertvector(v, bf16x2_t); return __builtin_bit_cast(unsigned, b); }
#define pack8(X, s) __builtin_bit_cast(bf16x8, (v4u){cvtpk((X)[8 * (s)], (X)[8 * (s) + 1]), cvtpk((X)[8 * (s) + 2], (X)[8 * (s) + 3]), cvtpk((X)[8 * (s) + 4], (X)[8 * (s) + 5]), cvtpk((X)[8 * (s) + 6], (X)[8 * (s) + 7])})
#define RLX_AGENT __ATOMIC_RELAXED, __HIP_MEMORY_SCOPE_AGENT
#define LDS_WAIT() asm volatile("s_waitcnt lgkmcnt(0)" ::: "memory")
#define VM_WAIT() asm volatile("s_waitcnt vmcnt(0)" ::: "memory")
__device__ __forceinline__ unsigned f2bf(float f) { unsigned u = __builtin_bit_cast(unsigned, f); return (u + 0x7fffu + ((u >> 16) & 1u)) >> 16; }
__device__ __forceinline__ unsigned pk2(float lo, float hi) { return f2bf(lo) | (f2bf(hi) << 16); }
__device__ __forceinline__ float bflo(unsigned u) { return __builtin_bit_cast(float, u << 16); }
__device__ __forceinline__ float bfhi(unsigned u) { return __builtin_bit_cast(float, u & 0xffff0000u); }
__device__ __forceinline__ float wave_sum(float v) {
#pragma unroll
    for (int o = 1; o < 64; o <<= 1) v += __shfl_xor(v, o);
    return v;
}
__device__ __forceinline__ float siluf(float x) { return x * __builtin_amdgcn_rcpf(1.0f + __expf(-x)); }

#define XB_TMO      128
#define XB_XCNT(j)  (256  + 64 * (j))
#define XB_XSUB(j)  (1280 + 64 * (j))
#define XB_XGEN(j)  (2304 + 64 * (j))
#define XB_TOP      3328
#define XB_TOPGEN   3392
#define XCD_BAR_WORDS 3456
#define XB_SPIN_CAP (1u << 18)
__device__ __forceinline__ unsigned xb_ld(unsigned* p)              { return __hip_atomic_load(p, __ATOMIC_RELAXED, __HIP_MEMORY_SCOPE_AGENT); }
__device__ __forceinline__ unsigned xb_add(unsigned* p, unsigned v) { return __hip_atomic_fetch_add(p, v, __ATOMIC_RELAXED, __HIP_MEMORY_SCOPE_AGENT); }
__device__ __forceinline__ unsigned xb_xcc_id() { return (unsigned)__builtin_amdgcn_s_getreg((3 << 11) | 20) & 0xFu; }
#define XB_SPIN(cond, bar) do { unsigned _sp = 0; while (cond) { __builtin_amdgcn_s_sleep(1); \
    if ((++_sp & 255u) == 0u) { if (xb_ld(&(bar)[XB_TMO])) break; if (_sp > XB_SPIN_CAP) { atomicAdd(&(bar)[XB_TMO], 1u); break; } } } } while (0)
struct XcdBarrier { unsigned* bar; unsigned x; volatile LAS unsigned* st; int wv; };
#define XB_T0(wv) ((wv) == 0 && lane_id_v() == 0)
__device__ __forceinline__ XcdBarrier xcd_barrier_post(unsigned* bar, volatile LAS unsigned* st, int wv) {
    XcdBarrier b; b.bar = bar; b.x = xb_xcc_id(); b.st = st; b.wv = wv;
    if (XB_T0(wv)) (void)xb_add(&bar[XB_XCNT(b.x)], 1u);
    return b;
}
__device__ __forceinline__ void xcd_barrier_complete(unsigned* bar, unsigned x, unsigned& nloc, unsigned& nx) {
    const unsigned G = gridDim.x * gridDim.y * gridDim.z;
    unsigned sum, cnt, mine, sp = 0u;
    for (;;) {
        sum = 0u; cnt = 0u; mine = 0u;
#pragma unroll
        for (unsigned j = 0; j < 16; ++j) { const unsigned c = xb_ld(&bar[XB_XCNT(j)]); sum += c; cnt += (c > 0u) ? 1u : 0u; mine = (j == x) ? c : mine; }
        if (sum == G) break;
        __builtin_amdgcn_s_sleep(1);
        if ((++sp & 255u) == 0u) { if (xb_ld(&bar[XB_TMO])) break; if (sp > XB_SPIN_CAP) { atomicAdd(&bar[XB_TMO], 1u); break; } }
    }
    nloc = mine > 0u ? mine : 1u; nx = cnt > 0u ? cnt : 1u;
}
__device__ __forceinline__ void xcd_barrier(const XcdBarrier& b) {
    asm volatile("s_waitcnt vmcnt(0)" ::: "memory");
    __syncthreads();
    if (XB_T0(b.wv)) {
        unsigned* bar = b.bar;
        __builtin_amdgcn_s_waitcnt(0);
        unsigned nloc = b.st[0], nx = b.st[1];
        if (nloc == 0u) { xcd_barrier_complete(bar, b.x, nloc, nx); b.st[0] = nloc; b.st[1] = nx; }
        const unsigned old = xb_add(&bar[XB_XSUB(b.x)], 1u);
        const unsigned gen = old / nloc;
        if (old + 1u == (gen + 1u) * nloc) {
            __builtin_amdgcn_fence(__ATOMIC_RELEASE, "agent");
            asm volatile("s_waitcnt vmcnt(0)" ::: "memory");
            const unsigned og = xb_add(&bar[XB_TOP], 1u);
            const unsigned tg = og / nx;
            if (og + 1u == (tg + 1u) * nx) xb_add(&bar[XB_TOPGEN], 1u);
            else XB_SPIN(xb_ld(&bar[XB_TOPGEN]) == tg, bar);
            __builtin_amdgcn_fence(__ATOMIC_ACQUIRE, "agent");
            xb_add(&bar[XB_XGEN(b.x)], 1u);
            asm volatile("s_waitcnt vmcnt(0)" ::: "memory");
        } else {
            XB_SPIN(xb_ld(&bar[XB_XGEN(b.x)]) == gen, bar);
            __builtin_amdgcn_fence(__ATOMIC_ACQUIRE, "agent");
            asm volatile("s_waitcnt vmcnt(0)" ::: "memory");
        }
    }
    __syncthreads();
}

__device__ __forceinline__ void transpose_item(const float* W, int ldw, int scol0, int k0, bf16* WT, int K, int drow0, LAS float* scr, int lane, const float* kscale) {
    f32x4 v[16];
    f32x4 s0 = (f32x4){1.f, 1.f, 1.f, 1.f}, s1 = s0;
    if (kscale) { s0 = *(const f32x4*)(kscale + k0 + 8 * (lane & 7)); s1 = *(const f32x4*)(kscale + k0 + 8 * (lane & 7) + 4); }
    const float* src = W + (size_t)(k0 + (lane >> 4)) * ldw + scol0 + 4 * (lane & 15);
#pragma unroll
    for (int i = 0; i < 16; ++i) v[i] = __builtin_nontemporal_load((const f32x4*)(src + (size_t)(4 * i) * ldw));
#pragma unroll
    for (int i = 0; i < 16; ++i) { LAS float* d = scr + (4 * i + (lane >> 4)) * 65 + 4 * (lane & 15); d[0] = v[i].x; d[1] = v[i].y; d[2] = v[i].z; d[3] = v[i].w; }
    LDS_WAIT(); asm volatile("" ::: "memory");
#pragma unroll
    for (int q = 0; q < 8; ++q) { const int t = lane + 64 * q, n = t >> 3, c8 = t & 7; const LAS float* sp = scr + (8 * c8) * 65 + n;
        float e[8];
#pragma unroll
        for (int j = 0; j < 8; ++j) e[j] = sp[j * 65];
        v4u o; o.x = cvtpk(e[0] * s0.x, e[1] * s0.y); o.y = cvtpk(e[2] * s0.z, e[3] * s0.w); o.z = cvtpk(e[4] * s1.x, e[5] * s1.y); o.w = cvtpk(e[6] * s1.z, e[7] * s1.w);
        __builtin_nontemporal_store(o, (GAS v4u*)(WT + (size_t)(drow0 + n) * K + k0 + 8 * c8)); }
    LDS_WAIT(); asm volatile("" ::: "memory");
}

__device__ __forceinline__ void gdn_prep(LAS unsigned char* lds, const int wave, const int wgi, const int nwg, const int clo, const int chi,
                                         const bf16* PROJ, const float* conv_qkv_w, const float* BA, const float* a_log, const float* dt_bias, unsigned char* GI, float* DSC) {
        LAS bf16* KNt = (LAS bf16*)(lds + P2_KN); LAS bf16* QNt = (LAS bf16*)(lds + P2_QN); LAS bf16* KTt = (LAS bf16*)(lds + P2_KT); LAS bf16* VTt = (LAS bf16*)(lds + P2_VT);
        LAS float* AMt = (LAS float*)(lds + P2_AM); LAS bf16* ATt = (LAS bf16*)(lds + P2_AT); LAS float* SMt = (LAS float*)(lds + P2_SM); LAS bf16* XTt = (LAS bf16*)(lds + P2_XT);
        LAS bf16* TUt = (LAS bf16*)(lds + P2_TU); LAS bf16* TWt = (LAS bf16*)(lds + P2_TW);
        v4u raw[3][4][2];
#define P2_RAWLOAD(qi_) do { const int ch_ = chi - 1 - (qi_) / (BATCH * NH), bh_ = (qi_) % (BATCH * NH); const int l_ = lane_id_v(), t_ = wave * 64 + l_, row_ = t_ >> 3, c0_ = (t_ & 7) * 16; \
            const int tt_ = ch_ * 64 + row_; const size_t tok_ = (size_t)(bh_ / NH) * SEQ + tt_; \
            _Pragma("unroll") for (int ten = 0; ten < 3; ++ten) { const bf16* src_ = PROJ + (size_t)ten * PROJ_T + tok_ * 1024 + (bh_ % NH) * 128 + c0_; \
                _Pragma("unroll") for (int j = 0; j < 4; ++j) { \
                    if (tt_ - 3 + j >= 0) { const v4u* p_ = (const v4u*)(src_ + (ptrdiff_t)(j - 3) * 1024); raw[ten][j][0] = p_[0]; raw[ten][j][1] = p_[1]; } \
                    else { raw[ten][j][0] = (v4u){0u, 0u, 0u, 0u}; raw[ten][j][1] = (v4u){0u, 0u, 0u, 0u}; } } } } while (0)
        if (wgi < (chi - clo) * BATCH * NH) P2_RAWLOAD(wgi);
        LAS float* CWt = (LAS float*)(lds + P2_CW); int cw_h = -1;
        for (int qi = wgi; qi < (chi - clo) * BATCH * NH; qi += nwg) {
            const int un_ch = chi - 1 - qi / (BATCH * NH), un_bh = qi % (BATCH * NH);
            const int laneu = lane_id_v(), tidu = wave * 64 + laneu;
            const int b = un_bh / NH, ch = un_ch, h = un_bh % NH, t0 = b * SEQ + ch * 64;
            const int uid = (b * NH + h) * (SEQ / 64) + ch;
            unsigned char* ub = (unsigned char*)GI + (size_t)uid * GI_UNIT;
            if (h != cw_h) {
                asm volatile("s_waitcnt lgkmcnt(0)" ::: "memory"); __builtin_amdgcn_s_barrier(); asm volatile("" ::: "memory");
#pragma unroll
                for (int i = 0; i < 3; ++i) { const int idx = tidu + NWAVES * 64 * i, ten = idx >> 9, j = (idx >> 7) & 3, c = idx & 127; CWt[idx] = conv_qkv_w[(size_t)j * 3072 + ten * 1024 + h * 128 + c]; }
                asm volatile("s_waitcnt lgkmcnt(0)" ::: "memory"); __builtin_amdgcn_s_barrier(); asm volatile("" ::: "memory");
                cw_h = h; }
            {
                const int row = tidu >> 3, c0 = (tidu & 7) * 16, tt = ch * 64 + row;
                float bl = 0.f, al = 0.f;
                if (wave == 0) { bl = BA[(size_t)(t0 + laneu) * 16 + h]; al = BA[(size_t)(t0 + laneu) * 16 + 8 + h]; }
#pragma unroll
                for (int ten = 0; ten < 3; ++ten) {
                    float acc[16];
#pragma unroll
                    for (int i = 0; i < 16; ++i) acc[i] = 0.f;
#pragma unroll
                    for (int j = 0; j < 4; ++j) {
                        {
                            const v4u a = raw[ten][j][0], bb = raw[ten][j][1];
                            const LAS f32x4* wp = (const LAS f32x4*)(CWt + (ten * 4 + j) * 128 + c0); const f32x4 w0 = wp[0], w1 = wp[1], w2 = wp[2], w3 = wp[3];
                            acc[0] += bflo(a.x) * w0.x; acc[1] += bfhi(a.x) * w0.y; acc[2] += bflo(a.y) * w0.z; acc[3] += bfhi(a.y) * w0.w;
                            acc[4] += bflo(a.z) * w1.x; acc[5] += bfhi(a.z) * w1.y; acc[6] += bflo(a.w) * w1.z; acc[7] += bfhi(a.w) * w1.w;
                            acc[8] += bflo(bb.x) * w2.x; acc[9] += bfhi(bb.x) * w2.y; acc[10] += bflo(bb.y) * w2.z; acc[11] += bfhi(bb.y) * w2.w;
                            acc[12] += bflo(bb.z) * w3.x; acc[13] += bfhi(bb.z) * w3.y; acc[14] += bflo(bb.w) * w3.z; acc[15] += bfhi(bb.w) * w3.w;
                        }
                    }
                    float ss = 0.f;
#pragma unroll
                    for (int i = 0; i < 16; ++i) { acc[i] = siluf(acc[i]); ss += acc[i] * acc[i]; }
                    ss += __shfl_xor(ss, 1); ss += __shfl_xor(ss, 2); ss += __shfl_xor(ss, 4);
                    const float sc = (ten == 0) ? rsqrtf(ss + EPS) * 0.08838834764831845f : (ten == 1 ? rsqrtf(ss + EPS) : 1.f);
                    unsigned pw[8];
#pragma unroll
                    for (int i = 0; i < 8; ++i) pw[i] = cvtpk(acc[2 * i] * sc, acc[2 * i + 1] * sc);
                    if (ten < 2) { v4u o0, o1; o0.x = pw[0]; o0.y = pw[1]; o0.z = pw[2]; o0.w = pw[3]; o1.x = pw[4]; o1.y = pw[5]; o1.z = pw[6]; o1.w = pw[7];
                        LAS v4u* dst = (LAS v4u*)((ten == 0 ? QNt : KNt) + row * 136 + c0); dst[0] = o0; dst[1] = o1; }
                    if (ten >= 1) { LAS bf16* tp = (ten == 1 ? KTt : VTt) + c0 * 72 + row;
#pragma unroll
                        for (int i = 0; i < 8; ++i) { tp[(2 * i) * 72] = (bf16)pw[i]; tp[(2 * i + 1) * 72] = (bf16)(pw[i] >> 16); } }
                }
                if (wave == 0) {
                    const float xs = al + dt_bias[h]; const float sp = xs > 20.f ? xs : __logf(1.0f + __expf(xs));
                    float gcv = -__expf(a_log[h]) * sp;
#pragma unroll
                    for (int o = 1; o < 64; o <<= 1) { const float v = __shfl_up(gcv, o); if (laneu >= o) gcv += v; }
                    const float gl = __shfl(gcv, 63);
                    SMt[laneu] = gcv; SMt[64 + laneu] = __expf(gcv); SMt[128 + laneu] = __expf(gl - gcv); SMt[192 + laneu] = __builtin_amdgcn_rcpf(1.0f + __expf(-bl));
                    if (laneu == 0) DSC[uid] = __expf(gl);
                }
            }
            asm volatile("s_waitcnt lgkmcnt(0)" ::: "memory"); __builtin_amdgcn_s_barrier(); asm volatile("" ::: "memory");
            {
                const int mat = wave >> 2, mb = wave & 3, fr = laneu & 15, fg = laneu >> 4;
                const LAS bf16* Am = mat ? QNt : KNt;
                pg8::bf16x8 af[4], bfr[4][4];
#pragma unroll
                for (int ks = 0; ks < 4; ++ks) af[ks] = *(const LAS pg8::bf16x8*)(Am + (16 * mb + fr) * 136 + 32 * ks + 8 * fg);
#pragma unroll
                for (int nb = 0; nb < 4; ++nb)
#pragma unroll
                    for (int ks = 0; ks < 4; ++ks) bfr[nb][ks] = *(const LAS pg8::bf16x8*)(KNt + (16 * nb + fr) * 136 + 32 * ks + 8 * fg);
                float gi[4], bi[4], gj[4];
#pragma unroll
                for (int r = 0; r < 4; ++r) { gi[r] = SMt[16 * mb + 4 * fg + r]; bi[r] = SMt[192 + 16 * mb + 4 * fg + r]; gj[r] = SMt[16 * r + fr]; }
                pg8::f32x4 acc[4];
#pragma unroll
                for (int nb = 0; nb < 4; ++nb) acc[nb] = (pg8::f32x4){0.f, 0.f, 0.f, 0.f};
#pragma unroll
                for (int ks = 0; ks < 4; ++ks)
#pragma unroll
                    for (int nb = 0; nb < 4; ++nb) acc[nb] = __builtin_amdgcn_mfma_f32_16x16x32_bf16(af[ks], bfr[nb][ks], acc[nb], 0, 0, 0);
#pragma unroll
                for (int nb = 0; nb < 4; ++nb) {
                    const int j = 16 * nb + fr; f32x4 av; unsigned short tv[4];
#pragma unroll
                    for (int r = 0; r < 4; ++r) {
                        const int i = 16 * mb + 4 * fg + r;
                        const float dec = (i >= j) ? __expf(gi[r] - gj[nb]) : 0.f;
                        av[r] = (i > j) ? bi[r] * acc[nb][r] * dec : 0.f;
                        tv[r] = (unsigned short)f2bf(acc[nb][r] * dec);
                    }
                    if (mat == 0) *(LAS f32x4*)(AMt + j * 68 + 16 * mb + 4 * fg) = av;
                    else {
#pragma unroll
                        for (int r = 0; r < 4; ++r) ATt[(16 * mb + 4 * fg + r) * 72 + j] = (bf16)tv[r]; }
                }
            }
            asm volatile("s_waitcnt lgkmcnt(0)" ::: "memory"); __builtin_amdgcn_s_barrier(); asm volatile("" ::: "memory");
            if (wave == 0) {
                const int c = laneu; f32x4 xq[16];
#pragma unroll
                for (int i = 0; i < 64; ++i) xq[i >> 2][i & 3] = (i == c) ? 1.f : 0.f;
                const LAS float* AMb = AMt; asm volatile("" : "+v"(AMb));
#pragma unroll
                for (int bq = 0; bq < 16; ++bq) {
                    const f32x4 d0 = *(const LAS f32x4*)(AMb + (4 * bq) * 68 + 4 * bq), d1 = *(const LAS f32x4*)(AMb + (4 * bq + 1) * 68 + 4 * bq), d2 = *(const LAS f32x4*)(AMb + (4 * bq + 2) * 68 + 4 * bq);
                    const float x0 = xq[bq].x;
                    const float x1 = xq[bq].y - d0.y * x0;
                    const float x2 = (xq[bq].z - d0.z * x0) - d1.z * x1;
                    const float x3 = ((xq[bq].w - d0.w * x0) - d1.w * x1) - d2.w * x2;
                    xq[bq] = (f32x4){x0, x1, x2, x3};
#pragma unroll
                    for (int q = bq + 1; q < 16; ++q) {
                        const f32x4 r0 = *(const LAS f32x4*)(AMb + (4 * bq) * 68 + 4 * q), r1 = *(const LAS f32x4*)(AMb + (4 * bq + 1) * 68 + 4 * q), r2 = *(const LAS f32x4*)(AMb + (4 * bq + 2) * 68 + 4 * q), r3 = *(const LAS f32x4*)(AMb + (4 * bq + 3) * 68 + 4 * q);
                        xq[q] -= (r0 * x0 + r1 * x1) + (r2 * x2 + r3 * x3);
                    }
                }
                const float su = SMt[192 + c], sw = -SMt[192 + c] * SMt[64 + c];
#pragma unroll
                for (int i = 0; i < 64; i += 2) { const unsigned pu = cvtpk(xq[i >> 2][i & 3] * su, xq[(i + 1) >> 2][(i + 1) & 3] * su), pw2 = cvtpk(xq[i >> 2][i & 3] * sw, xq[(i + 1) >> 2][(i + 1) & 3] * sw);
                    TUt[i * 72 + c] = (bf16)pu; TUt[(i + 1) * 72 + c] = (bf16)(pu >> 16); TWt[i * 72 + c] = (bf16)pw2; TWt[(i + 1) * 72 + c] = (bf16)(pw2 >> 16); }
            } else if (wave < 4) {
            } else {
                const int t2 = tidu - 256;
#pragma unroll 1
                for (int q = 0; q < 4; ++q) {
                    const int p = t2 + 256 * q, blk = p >> 6, l = p & 63, r = l & 31, hh = l >> 5, mb = blk >> 3, ks = blk & 7, i = 32 * mb + r;
                    const v2u lo = *(const LAS v2u*)(QNt + i * 136 + 16 * ks + 4 * hh), hi2 = *(const LAS v2u*)(QNt + i * 136 + 16 * ks + 8 + 4 * hh); const float e = SMt[64 + i];
                    v4u o; o.x = pk2(bflo(lo.x) * e, bfhi(lo.x) * e); o.y = pk2(bflo(lo.y) * e, bfhi(lo.y) * e); o.z = pk2(bflo(hi2.x) * e, bfhi(hi2.x) * e); o.w = pk2(bflo(hi2.y) * e, bfhi(hi2.y) * e);
                    *(v4u*)(ub + GI_QD + (size_t)p * 16) = o;
                }
#pragma unroll 1
                for (int q = 0; q < 4; ++q) {
                    const int p = t2 + 256 * q, blk = p >> 6, l = p & 63, r = l & 31, hh = l >> 5, mb = blk >> 2, ks = blk & 3, d = 32 * mb + r;
                    float v[8];
#pragma unroll
                    for (int j = 0; j < 8; ++j) { const int ip = 16 * ks + 8 * (j >> 2) + 4 * hh + (j & 3); v[j] = bflo(KNt[ip * 136 + d]) * SMt[128 + ip]; }
                    v4u o; o.x = pk2(v[0], v[1]); o.y = pk2(v[2], v[3]); o.z = pk2(v[4], v[5]); o.w = pk2(v[6], v[7]);
                    *(v4u*)(ub + GI_KD + (size_t)p * 16) = o;
                }
#pragma unroll 1
                for (int q = 0; q < 2; ++q) {
                    const int p = t2 + 256 * q, blk = p >> 6, l = p & 63, r = l & 31, hh = l >> 5, mb = blk >> 2, ks = blk & 3, i = 32 * mb + r;
                    const v2u lo = *(const LAS v2u*)(ATt + i * 72 + 16 * ks + 4 * hh), hi2 = *(const LAS v2u*)(ATt + i * 72 + 16 * ks + 8 + 4 * hh);
                    v4u o; o.x = lo.x; o.y = lo.y; o.z = hi2.x; o.w = hi2.y;
                    *(v4u*)(ub + GI_AT + (size_t)p * 16) = o;
                }
            }
            asm volatile("s_waitcnt lgkmcnt(0)" ::: "memory"); __builtin_amdgcn_s_barrier(); asm volatile("" ::: "memory");
            if (qi + nwg < (chi - clo) * BATCH * NH) P2_RAWLOAD(qi + nwg);
            {
                const int mat = wave >> 2, mb = wave & 3, fr = laneu & 15, fg = laneu >> 4;
                const LAS bf16* Tm = mat ? TWt : TUt; const LAS bf16* Bm = mat ? KTt : VTt;
                const pg8::bf16x8 a0 = *(const LAS pg8::bf16x8*)(Tm + (16 * mb + fr) * 72 + 8 * fg), a1 = *(const LAS pg8::bf16x8*)(Tm + (16 * mb + fr) * 72 + 32 + 8 * fg);
                pg8::bf16x8 b0[8], b1[8];
#pragma unroll
                for (int nb = 0; nb < 8; ++nb) { b0[nb] = *(const LAS pg8::bf16x8*)(Bm + (16 * nb + fr) * 72 + 8 * fg); b1[nb] = *(const LAS pg8::bf16x8*)(Bm + (16 * nb + fr) * 72 + 32 + 8 * fg); }
                pg8::f32x4 acc[8];
#pragma unroll
                for (int nb = 0; nb < 8; ++nb) acc[nb] = __builtin_amdgcn_mfma_f32_16x16x32_bf16(a0, b0[nb], (pg8::f32x4){0.f, 0.f, 0.f, 0.f}, 0, 0, 0);
#pragma unroll
                for (int nb = 0; nb < 8; ++nb) acc[nb] = __builtin_amdgcn_mfma_f32_16x16x32_bf16(a1, b1[nb], acc[nb], 0, 0, 0);
#pragma unroll
                for (int nb = 0; nb < 8; ++nb) {
                    const unsigned p01 = cvtpk(acc[nb][0], acc[nb][1]), p23 = cvtpk(acc[nb][2], acc[nb][3]); LAS bf16* xp = XTt + (16 * mb + 4 * fg) * 264 + mat * 128 + 16 * nb + fr;
                    xp[0] = (bf16)p01; xp[264] = (bf16)(p01 >> 16); xp[528] = (bf16)p23; xp[792] = (bf16)(p23 >> 16);
                }
            }
            asm volatile("s_waitcnt lgkmcnt(0)" ::: "memory"); __builtin_amdgcn_s_barrier(); asm volatile("" ::: "memory");
            {
#pragma unroll 1
                for (int q = 0; q < 2; ++q) {
                    const int p = tidu + 512 * q, blk = p >> 6, l = p & 63, r = l & 31, hh = l >> 5, mb = blk >> 3, ks = blk & 7, i = 32 * mb + r;
                    const v2u lo = *(const LAS v2u*)(XTt + i * 264 + 128 + 16 * ks + 4 * hh), hi2 = *(const LAS v2u*)(XTt + i * 264 + 128 + 16 * ks + 8 + 4 * hh);
                    v4u o; o.x = lo.x; o.y = lo.y; o.z = hi2.x; o.w = hi2.y;
                    *(v4u*)(ub + GI_NW + (size_t)p * 16) = o;
                }
                {
                    const int p = tidu, blk = p >> 6, l = p & 63, r = l & 31, hh = l >> 5, nq = blk >> 1, mb = blk & 1, col = 32 * nq + r;
                    unsigned w[8];
#pragma unroll
                    for (int rg = 0; rg < 16; rg += 2) { const int i0 = 32 * mb + (rg & 3) + 8 * (rg >> 2) + 4 * hh; w[rg >> 1] = (unsigned)XTt[i0 * 264 + col] | ((unsigned)XTt[(i0 + 1) * 264 + col] << 16); }
                    v4u o0, o1; o0.x = w[0]; o0.y = w[1]; o0.z = w[2]; o0.w = w[3]; o1.x = w[4]; o1.y = w[5]; o1.z = w[6]; o1.w = w[7];
                    v4u* dst = (v4u*)(ub + GI_U + (size_t)p * 32); dst[0] = o0; dst[1] = o1;
                }
            }
            asm volatile("s_waitcnt lgkmcnt(0)" ::: "memory"); __builtin_amdgcn_s_barrier(); asm volatile("" ::: "memory");
        }
}

#undef P2_RAWLOAD
__device__ __forceinline__ void gdn_scan(LAS unsigned char* lds, const int wave, const int bh, const int half, const int c0, const int c1,
                                         const unsigned char* GI, const float* DSC, bf16* Y, float* SBUF) {
        {
            const int b = bh / NH, h = bh % NH; const int lane = lane_id_v(), tid = wave * 64 + lane;
            const unsigned char* gbase = (const unsigned char*)GI + (size_t)bh * (SEQ / 64) * GI_UNIT;
            LAS unsigned short* OB = (LAS unsigned short*)(lds + P3_OB);
            LAS unsigned char* UB = lds + P3_UB;
            LAS float* DL = (LAS float*)(lds + P3_DL);
            constexpr int NCH = SEQ / 64;
            if (tid < NCH) DL[tid] = DSC[bh * NCH + tid];
            if (wave == 2 || wave == 3) {
                asm volatile("s_waitcnt lgkmcnt(0)" ::: "memory"); __builtin_amdgcn_s_barrier();
                for (int c = c0; c < c1; ++c) { __builtin_amdgcn_s_barrier(); __builtin_amdgcn_s_barrier(); }
            } else if (wave < 2) {
                __builtin_amdgcn_s_setprio(3);
                const int nq = half * 2 + wave, r = lane & 31, hh = lane >> 5;
                f32x16 S[4], O[2];
#pragma unroll
                for (int i = 0; i < 16; ++i) { S[0][i] = 0.f; S[1][i] = 0.f; S[2][i] = 0.f; S[3][i] = 0.f; O[0][i] = 0.f; O[1][i] = 0.f; }
                float* sbp = SBUF + ((size_t)(bh * 4 + nq) * 64 + lane) * 64;
                if (c0 > 0) {
#pragma unroll
                    for (int t = 0; t < 4; ++t)
#pragma unroll
                        for (int q = 0; q < 4; ++q) { const f32x4 v = *(const f32x4*)(sbp + t * 16 + q * 4); S[t][4 * q] = v.x; S[t][4 * q + 1] = v.y; S[t][4 * q + 2] = v.z; S[t][4 * q + 3] = v.w; }
                }
#define P3_FOFF(i) ((i) < 32 ? ((((i) & 3) < 2 ? (int)GI_NW : (int)GI_QD) + ((((i) & 1) * 8 + ((i) >> 2)) * 64) * 16) \
                             : ((((i) - 32) % 6) < 2 ? (int)GI_AT + (((((i) - 32) % 6) * 4 + ((i) - 32) / 6) * 64) * 16 : (int)GI_KD + ((((((i) - 32) % 6) - 2) * 4 + ((i) - 32) / 6) * 64) * 16))
                constexpr int PD = 6;
                asm volatile("s_waitcnt lgkmcnt(0)" ::: "memory"); __builtin_amdgcn_s_barrier(); asm volatile("" ::: "memory");
                for (int c = c0; c < c1; ++c) {
                    const LAS unsigned char* ab = lds + (c & 1) * GI_DMA + lane * 16;
                    bf16x8 R[PD];
#pragma unroll
                    for (int i = 0; i < PD; ++i) R[i] = *(const LAS bf16x8*)(ab + P3_FOFF(i));
                    const float dcur = DL[c];
                    f32x16 V[2];
                    { const v4u ua = *(const LAS v4u*)(UB + ((nq * 2) * 64 + lane) * 32), ub2 = *(const LAS v4u*)(UB + ((nq * 2) * 64 + lane) * 32 + 16);
                      const v4u uc = *(const LAS v4u*)(UB + ((nq * 2 + 1) * 64 + lane) * 32), ud = *(const LAS v4u*)(UB + ((nq * 2 + 1) * 64 + lane) * 32 + 16);
                      V[0][0] = bflo(ua.x); V[0][1] = bfhi(ua.x); V[0][2] = bflo(ua.y); V[0][3] = bfhi(ua.y); V[0][4] = bflo(ua.z); V[0][5] = bfhi(ua.z); V[0][6] = bflo(ua.w); V[0][7] = bfhi(ua.w);
                      V[0][8] = bflo(ub2.x); V[0][9] = bfhi(ub2.x); V[0][10] = bflo(ub2.y); V[0][11] = bfhi(ub2.y); V[0][12] = bflo(ub2.z); V[0][13] = bfhi(ub2.z); V[0][14] = bflo(ub2.w); V[0][15] = bfhi(ub2.w);
                      V[1][0] = bflo(uc.x); V[1][1] = bfhi(uc.x); V[1][2] = bflo(uc.y); V[1][3] = bfhi(uc.y); V[1][4] = bflo(uc.z); V[1][5] = bfhi(uc.z); V[1][6] = bflo(uc.w); V[1][7] = bfhi(uc.w);
                      V[1][8] = bflo(ud.x); V[1][9] = bfhi(ud.x); V[1][10] = bflo(ud.y); V[1][11] = bfhi(ud.y); V[1][12] = bflo(ud.z); V[1][13] = bfhi(ud.z); V[1][14] = bflo(ud.w); V[1][15] = bfhi(ud.w); }
                    bf16x8 Sb[8], Vb[4];
                    Sb[0] = pack8(S[0], 0); Sb[1] = pack8(S[0], 1); Sb[2] = pack8(S[1], 0); Sb[3] = pack8(S[1], 1); Sb[4] = pack8(S[2], 0); Sb[5] = pack8(S[2], 1); Sb[6] = pack8(S[3], 0); Sb[7] = pack8(S[3], 1);
#pragma unroll
                    for (int i = 0; i < 16; ++i) { O[0][i] = 0.f; O[1][i] = 0.f; }
                    __builtin_amdgcn_sched_barrier(0);
#define P3_STEP(i) { const bf16x8 f_ = R[(i) % PD]; \
                        if ((i) < 32) { if (((i) & 3) < 2) V[(i) & 1] = __builtin_amdgcn_mfma_f32_32x32x16_bf16(f_, Sb[((i) >> 2) & 7], V[(i) & 1], 0, 0, 0); else O[(i) & 1] = __builtin_amdgcn_mfma_f32_32x32x16_bf16(f_, Sb[((i) >> 2) & 7], O[(i) & 1], 0, 0, 0); } \
                        else { if ((((i) - 32) % 6) < 2) O[(((i) - 32) % 6) & 1] = __builtin_amdgcn_mfma_f32_32x32x16_bf16(f_, Vb[(((i) - 32) / 6) & 3], O[(((i) - 32) % 6) & 1], 0, 0, 0); \
                               else S[((((i) - 32) % 6) - 2) & 3] = __builtin_amdgcn_mfma_f32_32x32x16_bf16(f_, Vb[(((i) - 32) / 6) & 3], S[((((i) - 32) % 6) - 2) & 3], 0, 0, 0); } \
                        if ((i) + PD < 56) R[(i) % PD] = *(const LAS bf16x8*)(ab + P3_FOFF(((i) + PD) % 56)); \
                        __builtin_amdgcn_sched_barrier(0); }
#define P3_STEP8(b) P3_STEP((b)) P3_STEP((b) + 1) P3_STEP((b) + 2) P3_STEP((b) + 3) P3_STEP((b) + 4) P3_STEP((b) + 5) P3_STEP((b) + 6) P3_STEP((b) + 7)
                    P3_STEP8(0) P3_STEP8(8) P3_STEP8(16) P3_STEP8(24)
                    Vb[0] = pack8(V[0], 0); Vb[1] = pack8(V[0], 1); Vb[2] = pack8(V[1], 0); Vb[3] = pack8(V[1], 1);
#pragma unroll
                    for (int q = 0; q < 16; ++q) { S[0][q] *= dcur; S[1][q] *= dcur; S[2][q] *= dcur; S[3][q] *= dcur; }
                    __builtin_amdgcn_sched_barrier(0);
                    P3_STEP8(32) P3_STEP8(40) P3_STEP8(48)
#undef P3_STEP8
#undef P3_STEP
                    asm volatile("s_waitcnt lgkmcnt(0)" ::: "memory"); __builtin_amdgcn_s_barrier(); asm volatile("" ::: "memory");
#pragma unroll
                    for (int rg = 0; rg < 16; ++rg) { const int row = (rg & 3) + 8 * (rg >> 2) + 4 * hh; const unsigned pk_ = cvtpk(O[0][rg], O[1][rg]); OB[row * 136 + 32 * nq + r] = (unsigned short)pk_; OB[(32 + row) * 136 + 32 * nq + r] = (unsigned short)(pk_ >> 16); }
                    asm volatile("s_waitcnt lgkmcnt(0)" ::: "memory"); __builtin_amdgcn_s_barrier(); asm volatile("" ::: "memory");
                }
#undef P3_FOFF
                if (c1 < NCH) {
#pragma unroll
                    for (int t = 0; t < 4; ++t)
#pragma unroll
                        for (int q = 0; q < 4; ++q) *(f32x4*)(sbp + t * 16 + q * 4) = (f32x4){S[t][4 * q], S[t][4 * q + 1], S[t][4 * q + 2], S[t][4 * q + 3]};
                }
                __builtin_amdgcn_s_setprio(0);
            } else {
                const int lw = wave - 4, lt = tid - 256;
                const __amdgpu_buffer_rsrc_t grsrc = __builtin_amdgcn_make_buffer_rsrc((void*)gbase, 0, (int)((SEQ / 64) * GI_UNIT), 0x00020000);
                v4u ra[14], ru_a[2], rb[14], ru_b[2];
#define P3_LOAD(rs, ru, ch) do { const int so_ = (ch) * (int)GI_UNIT; \
        _Pragma("unroll") for (int k_ = 0; k_ < 14; ++k_) rs[k_] = __builtin_amdgcn_raw_buffer_load_b128(grsrc, lt * 16, so_ + k_ * 4096, 0); \
        _Pragma("unroll") for (int k_ = 0; k_ < 2; ++k_) ru[k_] = __builtin_amdgcn_raw_buffer_load_b128(grsrc, lt * 16, so_ + (int)GI_U + half * 8192 + k_ * 4096, 0); } while (0)
#define P3_PUT(rs, bufi) do { LAS unsigned char* db_ = lds + (bufi) * GI_DMA; _Pragma("unroll") for (int k_ = 0; k_ < 14; ++k_) *(LAS v4u*)(db_ + (k_ * 256 + lt) * 16) = rs[k_]; } while (0)
#define P3_PUTU(ru) do { _Pragma("unroll") for (int k_ = 0; k_ < 2; ++k_) *(LAS v4u*)(UB + half * 8192 + (k_ * 256 + lt) * 16) = ru[k_]; } while (0)
#define P3_OCOPY(cprev) do { const int tb_ = b * SEQ + (cprev) * 64, row_ = lw * 16 + (lane >> 2), sg_ = lane & 3; \
        _Pragma("unroll") for (int q_ = 0; q_ < 2; ++q_) { const v4u ov_ = *(const LAS v4u*)(OB + row_ * 136 + half * 64 + sg_ * 16 + q_ * 8); \
            *(v4u*)(Y + (size_t)(tb_ + row_) * D + h * 128 + half * 64 + sg_ * 16 + q_ * 8) = ov_; } } while (0)
#define P3_BAR() do { asm volatile("s_waitcnt lgkmcnt(0)" ::: "memory"); __builtin_amdgcn_s_barrier(); asm volatile("" ::: "memory"); } while (0)
                P3_LOAD(ra, ru_a, c0); P3_LOAD(rb, ru_b, c0 + 1);
                P3_PUT(ra, 0); P3_PUTU(ru_a);
                P3_LOAD(ra, ru_a, c0 + 2);
                P3_BAR();
                for (int c = c0; c < c1; c += 2) {
                    if (c + 1 < c1) P3_PUT(rb, 1);
                    if (c > c0) { P3_OCOPY(c - 1); }
                    P3_BAR();
                    if (c + 1 < c1) P3_PUTU(ru_b);
                    if (c + 3 < c1) P3_LOAD(rb, ru_b, c + 3);
                    P3_BAR();
                    if (c + 2 < c1) P3_PUT(ra, 0);
                    P3_OCOPY(c);
                    P3_BAR();
                    if (c + 2 < c1) P3_PUTU(ru_a);
                    if (c + 4 < c1) P3_LOAD(ra, ru_a, c + 4);
                    P3_BAR();
                }
                P3_OCOPY(c1 - 1);
#undef P3_LOAD
#undef P3_PUT
#undef P3_PUTU
#undef P3_OCOPY
#undef P3_BAR
            }
        }
}

struct Args { const float* in[18]; float* out; unsigned char* ws; int ph_lo, ph_hi; };

template <unsigned PMASK> __global__ void __launch_bounds__(NWAVES * 64, 2) fwd(Args args) {
    extern __shared__ __attribute__((aligned(16))) unsigned char lds_raw[];
    LAS unsigned char* lds = (LAS unsigned char*)lds_raw;
    const int wave = __builtin_amdgcn_readfirstlane((int)threadIdx.x >> 6);
#define PHASE_IDS const int lane = lane_id_v(), tid = wave * 64 + lane; (void)tid; (void)lane
    const int G = gridDim.x, gw = blockIdx.x * NWAVES + wave, NGW = G * NWAVES;
    unsigned char* ws = args.ws;
    const float* x = args.in[0]; const float* norm1_w = args.in[1]; const float* w_in = args.in[2]; const float* conv_qkv_w = args.in[3];
    const float* a_log = args.in[4]; const float* dt_bias = args.in[5]; const float* gdn_norm_w = args.in[6]; const float* conv_sc_w = args.in[7];
    const float* w_out = args.in[8]; const float* norm2_w = args.in[9]; const float* rgw = args.in[10]; const float* rgb = args.in[11];
    const float* rew = args.in[12]; const float* reb = args.in[13]; const float* w_gate = args.in[14]; const float* w_up = args.in[15];
    const float* w_down = args.in[16]; const float* final_w = args.in[17];
    float* out = args.out;
    float* BA = (float*)(ws + WS_BA); float* GB = (float*)(ws + WS_GB); float* RSTD = (float*)(ws + WS_RSTD);
    int* EID = (int*)(ws + WS_EID); float* GATE = (float*)(ws + WS_GATE); int* POS = (int*)(ws + WS_POS);
    float* ROWSC = (float*)(ws + WS_ROWSC); int* ROWTOK = (int*)(ws + WS_ROWTOK); float* ROWGATE = (float*)(ws + WS_ROWGATE); int* TILES = (int*)(ws + WS_TILES);
    bf16* WIN = (bf16*)(ws + WS_WIN); bf16* WOUT = (bf16*)(ws + WS_WOUT);
    bf16* HN = (bf16*)(ws + WS_R0); bf16* Y = (bf16*)(ws + WS_R0); bf16* HID = (bf16*)(ws + WS_R0);
    bf16* PROJ = (bf16*)(ws + WS_R1); bf16* WGU = (bf16*)(ws + WS_R1); bf16* WDN = (bf16*)(ws + WS_R1 + 320 * MiB);
    float* SBUF = (float*)(ws + WS_SBUF); unsigned char* GI = ws + WS_R3; int* CNT = (int*)(ws + WS_CTL + 65536);     bf16* WR = (bf16*)(ws + WS_WR); float* SSQ = (float*)(ws + WS_SSQ); bf16* H1B = (bf16*)(ws + WS_H1B); float* DSC = (float*)(ws + WS_DSC); bf16* XG = (bf16*)(ws + WS_R3); bf16* YMOE = (bf16*)(ws + WS_R3);
    const int lo = args.ph_lo, hi = args.ph_hi;
    { PHASE_IDS; for (int u = tid; u < (LDS_BYTES - LDSCTL_OFF) / 4; u += NWAVES * 64) ((LAS unsigned*)(lds + LDSCTL_OFF))[u] = 0u; }
    __syncthreads();
    XcdBarrier bar; bar.bar = (unsigned*)(ws + WS_CTL) + 4096; bar.x = 0; bar.st = nullptr; bar.wv = wave;
    if (hi - lo > 1) bar = xcd_barrier_post((unsigned*)(ws + WS_CTL) + 4096, (volatile LAS unsigned*)(lds + MISC_OFF) + 8, wave);
    const unsigned bar_x = __builtin_amdgcn_readfirstlane(bar.x);
#define SEAM(k) do { if (IN(k) && IN((k) + 1)) { unsigned* bp_ = (unsigned*)(ws + WS_CTL) + 4096; asm volatile("" : "+s"(bp_)); XcdBarrier b_; b_.bar = bp_; b_.x = bar_x; b_.st = (volatile LAS unsigned*)(lds + MISC_OFF) + 8; b_.wv = wave; xcd_barrier(b_); } } while (0)
#ifndef PROBE_MASK
#define PROBE_MASK 0u
#endif
#define SEAM_ALWAYS do { unsigned* bp_ = (unsigned*)(ws + WS_CTL) + 4096; asm volatile("" : "+s"(bp_)); XcdBarrier b_; b_.bar = bp_; b_.x = bar_x; b_.st = (volatile LAS unsigned*)(lds + MISC_OFF) + 8; b_.wv = wave; xcd_barrier(b_); } while (0)
#define PH_BEGIN(k) _Pragma("unroll") for (int rep_ = 0; rep_ < (((PROBE_MASK >> (k)) & 1u) ? 2 : 1); ++rep_) if (IN(k)) { if (rep_ > 0) SEAM_ALWAYS;
#define IN(k) (((PMASK >> (k)) & 1u) && lo <= (k) && (k) < hi)

    PH_BEGIN(0)
        PHASE_IDS;
        LAS float* scr = (LAS float*)(lds + wave * 16640);
        constexpr int I_IN = (D / 64) * (NPROJ / 64), I_OUT = (D / 64) * (D / 64);
        for (int it = gw; it < I_IN + I_OUT; it += NGW) {
            if (it < I_IN) { const int kb = it / (NPROJ / 64), nb = it % (NPROJ / 64), n0 = nb * 64; transpose_item(w_in, IN_COLS, n0 < 4096 ? n0 : n0 + 16, kb * 64, WIN, D, n0, scr, lane, nullptr); }
            else { const int r = it - I_IN, kb = r / (D / 64), nb = r % (D / 64); transpose_item(w_out, D, nb * 64, kb * 64, WOUT, D, nb * 64, scr, lane, nullptr); }
        }
        for (int item = wave * G + (int)blockIdx.x; item < 320; item += NGW) {
            if (item < 256) { const int k0 = item * 8; float v[8];
#pragma unroll
                for (int j = 0; j < 8; ++j) v[j] = rew[(size_t)(k0 + j) * 64 + lane] * norm2_w[k0 + j];
                v4u o; o.x = pk2(v[0], v[1]); o.y = pk2(v[2], v[3]); o.z = pk2(v[4], v[5]); o.w = pk2(v[6], v[7]);
                *(v4u*)(WR + (size_t)(8 + lane) * D + k0) = o; }
            else if (item < 288) { const int p = (item - 256) * 64 + lane, gq = p & 7, k0 = (p >> 3) * 8; float v[8];
#pragma unroll
                for (int j = 0; j < 8; ++j) v[j] = rgw[(size_t)(k0 + j) * 8 + gq] * norm2_w[k0 + j];
                v4u o; o.x = pk2(v[0], v[1]); o.y = pk2(v[2], v[3]); o.z = pk2(v[4], v[5]); o.w = pk2(v[6], v[7]);
                *(v4u*)(WR + (size_t)gq * D + k0) = o; }
            else { const int p = (item - 288) * 64 + lane; *(v4u*)(WR + (size_t)(72 + (p >> 8)) * D + (p & 255) * 8) = (v4u){0u, 0u, 0u, 0u}; }
        }
        __syncthreads();
        LAS bf16* wbl = (LAS bf16*)lds;
        for (int idx = tid; idx < 16 * D; idx += NWAVES * 64) { const int k = idx >> 4, c = idx & 15; wbl[c * 2056 + k] = (bf16)f2bf(w_in[(size_t)k * IN_COLS + 4096 + c]); }
        __syncthreads();
        for (int blk = gw; blk < T / 16; blk += NGW) {
#define P0_RW(r_) ((r_) * (T / 16) + blk)
            f32x4 nxa[8], nxb[8];
#define P0_LD(dst, rowi) do { const f32x4* xr_ = (const f32x4*)(x + (size_t)(rowi) * D) + lane; _Pragma("unroll") for (int j = 0; j < 8; ++j) dst[j] = xr_[64 * j]; } while (0)
#define P0_ROW(src, m_) do { f32x4 v[8]; float ss = 0.f; \
                _Pragma("unroll") for (int j = 0; j < 8; ++j) { v[j] = src[j]; ss += (v[j].x * v[j].x + v[j].y * v[j].y) + (v[j].z * v[j].z + v[j].w * v[j].w); } \
                const float rstd = rsqrtf(wave_sum(ss) * (1.f / D) + EPS); v2u* o8 = (v2u*)(HN + (size_t)(m_) * D) + lane; \
                _Pragma("unroll") for (int j = 0; j < 8; ++j) { v[j] = v[j] * rstd * wn1[j]; v2u o; o.x = cvtpk(v[j].x, v[j].y); o.y = cvtpk(v[j].z, v[j].w); o8[64 * j] = o; } } while (0)
            f32x4 wn1[8];
#pragma unroll
            for (int j = 0; j < 8; ++j) wn1[j] = *((const f32x4*)norm1_w + lane + 64 * j);
            P0_LD(nxa, P0_RW(0)); P0_LD(nxb, P0_RW(1));
#pragma unroll 1
            for (int r = 0; r < 16; r += 2) {
                { f32x4 cur[8];
#pragma unroll
                  for (int j = 0; j < 8; ++j) cur[j] = nxa[j];
                  if (r + 2 < 16) P0_LD(nxa, P0_RW(r + 2));
                  P0_ROW(cur, P0_RW(r)); }
                { f32x4 cur[8];
#pragma unroll
                  for (int j = 0; j < 8; ++j) cur[j] = nxb[j];
                  if (r + 3 < 16) P0_LD(nxb, P0_RW(r + 3));
                  P0_ROW(cur, P0_RW(r + 1)); }
            }
#undef P0_LD
#undef P0_ROW
            asm volatile("s_waitcnt vmcnt(0)" ::: "memory");
            { const int fr = lane & 15, fg = lane >> 4;
              pg8::f32x4 acc = (pg8::f32x4){0.f, 0.f, 0.f, 0.f};
              const bf16* ap = HN + (size_t)P0_RW(fr) * D + 8 * fg; const LAS bf16* bp = wbl + fr * 2056 + 8 * fg;
#pragma unroll 1
              for (int k0 = 0; k0 < D; k0 += 256) {
                  pg8::bf16x8 a[8];
#pragma unroll
                  for (int u = 0; u < 8; ++u) a[u] = *(const pg8::bf16x8*)(ap + k0 + 32 * u);
#pragma unroll
                  for (int u = 0; u < 8; ++u) { const pg8::bf16x8 bq = *(const LAS pg8::bf16x8*)(bp + k0 + 32 * u); acc = __builtin_amdgcn_mfma_f32_16x16x32_bf16(a[u], bq, acc, 0, 0, 0); }
              }
#pragma unroll
              for (int r = 0; r < 4; ++r) BA[(size_t)P0_RW(4 * fg + r) * 16 + fr] = acc[r]; }
#undef P0_RW
        }
    }

    SEAM(0);
    PH_BEGIN(1)
        PHASE_IDS;
        pg8::Gemm g{HN, WIN, T, NPROJ, D}; pg8::StaticOrder S; S.init(T, NPROJ, G, (int)blockIdx.x);
        pg8::EpiBf16S E{PROJ, 1024, 1024, PROJ_T};
        pg8::gemm_phase<pg8::EpiBf16S, pg8::StaticOrder, PG8_ALIGN, PG8_SP2>(lds + RING_OFF, g, S, E, wave);
    }

    SEAM(1);
    PH_BEGIN(2)
        PHASE_IDS;
        const bf16* PB = PROJ + 4 * PROJ_T; const bf16* PC = PROJ + 5 * PROJ_T; const bf16* PH = PROJ + 6 * PROJ_T;
        f32x4 scw[3][4];
#pragma unroll
        for (int j = 0; j < 3; ++j) { const f32x4* wp = (const f32x4*)(conv_sc_w + (size_t)j * 1024 + 16 * lane); scw[j][0] = wp[0]; scw[j][1] = wp[1]; scw[j][2] = wp[2]; scw[j][3] = wp[3]; }
        for (int t = gw; t < T; t += NGW) {
            const int tt = t % SEQ, c0 = 16 * lane;
            float acc[16];
#pragma unroll
            for (int i = 0; i < 16; ++i) acc[i] = 0.f;
#pragma unroll
            for (int j = 0; j < 3; ++j) {
                if (tt - 2 + j >= 0) {
                    const v4u* pc = (const v4u*)(PC + (size_t)(t - 2 + j) * 1024 + c0); const v4u* ph = (const v4u*)(PH + (size_t)(t - 2 + j) * 1024 + c0);
                    const v4u a = pc[0], b = pc[1], e = ph[0], f = ph[1];
                    const f32x4 w0 = scw[j][0], w1 = scw[j][1], w2 = scw[j][2], w3 = scw[j][3];
                    acc[0] += bflo(a.x) * bflo(e.x) * w0.x; acc[1] += bfhi(a.x) * bfhi(e.x) * w0.y; acc[2] += bflo(a.y) * bflo(e.y) * w0.z; acc[3] += bfhi(a.y) * bfhi(e.y) * w0.w;
                    acc[4] += bflo(a.z) * bflo(e.z) * w1.x; acc[5] += bfhi(a.z) * bfhi(e.z) * w1.y; acc[6] += bflo(a.w) * bflo(e.w) * w1.z; acc[7] += bfhi(a.w) * bfhi(e.w) * w1.w;
                    acc[8] += bflo(b.x) * bflo(f.x) * w2.x; acc[9] += bfhi(b.x) * bfhi(f.x) * w2.y; acc[10] += bflo(b.y) * bflo(f.y) * w2.z; acc[11] += bfhi(b.y) * bfhi(f.y) * w2.w;
                    acc[12] += bflo(b.z) * bflo(f.z) * w3.x; acc[13] += bfhi(b.z) * bfhi(f.z) * w3.y; acc[14] += bflo(b.w) * bflo(f.w) * w3.z; acc[15] += bfhi(b.w) * bfhi(f.w) * w3.w;
                }
            }
            const v4u* pb = (const v4u*)(PB + (size_t)t * 1024 + c0); const v4u a = pb[0], b = pb[1];
            v4u o0, o1;
            o0.x = pk2(acc[0] * bflo(a.x), acc[1] * bfhi(a.x)); o0.y = pk2(acc[2] * bflo(a.y), acc[3] * bfhi(a.y)); o0.z = pk2(acc[4] * bflo(a.z), acc[5] * bfhi(a.z)); o0.w = pk2(acc[6] * bflo(a.w), acc[7] * bfhi(a.w));
            o1.x = pk2(acc[8] * bflo(b.x), acc[9] * bfhi(b.x)); o1.y = pk2(acc[10] * bflo(b.y), acc[11] * bfhi(b.y)); o1.z = pk2(acc[12] * bflo(b.z), acc[13] * bfhi(b.z)); o1.w = pk2(acc[14] * bflo(b.w), acc[15] * bfhi(b.w));
            v4u* dst = (v4u*)(Y + (size_t)t * D + 1024 + c0); dst[0] = o0; dst[1] = o1;
        }
        gdn_prep(lds, wave, (int)blockIdx.x, G, 0, GDN_SPLIT, PROJ, conv_qkv_w, BA, a_log, dt_bias, GI, DSC);
    }

    SEAM(2);
    PH_BEGIN(3)
#define P3_ITEM(isA_, it_) do { const int it = (it_); \
                if ((isA_) && it < 16384) { const int e = it >> 8, r = it & 255, kb = r >> 5, nb = r & 31; \
                    transpose_item(w_down + (size_t)e * DE * D, D, nb * 64, kb * 64, WDN, DE, e * 2048 + nb * 64, scr, lane, nullptr); } \
                else { const int q = (isA_) ? it - 16384 : it; const int e = ((isA_) ? 48 : 0) + (q >> 9); int r = q & 511; const int up = r >> 8; r &= 255; const int kb = r >> 3, nb = r & 7, n0 = nb * 64; \
                    transpose_item((up ? w_up : w_gate) + (size_t)e * D * DE, DE, n0, kb * 64, WGU, D, (e * 4 + (e >= 48 ? 64 : 0) + (n0 >> 7)) * 256 + up * 128 + (n0 & 127), scr, lane, norm2_w); } } while (0)
#define P3_CONVERT(part) do { const int lane = lane_id_v(); LAS float* scr = (LAS float*)(lds + wave * 16640); \
            const int nh = G - NSCAN, hidx = (int)blockIdx.x - NSCAN, cw = hidx * NWAVES + wave, ncw = nh * NWAVES; \
            const int NJ = (part) == 0 ? 20992 : 28160, EXTRA = (part) == 0 ? 2 : 4; \
            const int heavy = (part) == 0 ? (((SEQ / 64 - GDN_SPLIT) * BATCH * NH) % nh) : (((T / 256) * (D / 256)) % nh);     \
            const int nlw = (nh - heavy) * NWAVES; int R = heavy ? (NJ - EXTRA * nlw) / ncw : (NJ + ncw - 1) / ncw; if (R < 0) R = 0; \
            for (int k = 0; k < R; ++k) { const int J = cw + k * ncw; if (J < NJ) { if ((part) == 0) P3_ITEM(1, J); else if (J < 24576) P3_ITEM(0, J); else P3_ITEM(1, 20992 + (J - 24576)); } } \
            if (heavy && hidx >= heavy) for (int J = R * ncw + (hidx - heavy) * NWAVES + wave; J < NJ; J += nlw) { if ((part) == 0) P3_ITEM(1, J); else if (J < 24576) P3_ITEM(0, J); else P3_ITEM(1, 20992 + (J - 24576)); } } while (0)
        if (blockIdx.x < NSCAN) gdn_scan(lds, wave, (int)blockIdx.x & 15, (int)blockIdx.x >> 4, 0, GDN_SPLIT, GI, DSC, Y, SBUF);
        else {
            const bool copy_first = ((int)blockIdx.x & 1) != 0;
#pragma unroll 1
            for (int ph = 0; ph < 2; ++ph) {
                if ((ph == 0) != copy_first) gdn_prep(lds, wave, (int)blockIdx.x - NSCAN, G - NSCAN, GDN_SPLIT, SEQ / 64, PROJ, conv_qkv_w, BA, a_log, dt_bias, GI, DSC);
                else P3_CONVERT(0);
                __syncthreads();
            } }
        SEAM_ALWAYS;
        if (blockIdx.x < NSCAN) {
            gdn_scan(lds, wave, (int)blockIdx.x & 15, (int)blockIdx.x >> 4, GDN_SPLIT, SEQ / 64, GI, DSC, Y, SBUF);
        } else {
            const bool copy_first = ((int)blockIdx.x & 1) != 0;
#pragma unroll 1
            for (int ph = 0; ph < 2; ++ph) {
                if ((ph == 0) == copy_first) P3_CONVERT(1);
                else {
                    pg8::Gemm g{Y + 1024, WOUT + 1024, T, D, 1024, D}; pg8::StaticOrder S; S.init(T, D, G - NSCAN, (int)blockIdx.x - NSCAN);
                    pg8::EpiResB16 E{x, (bf16*)out, D};
                    pg8::gemm_phase<pg8::EpiResB16, pg8::StaticOrder, PG8_ALIGN, PG8_SP2>(lds + RING_OFF, g, S, E, wave); }
                __syncthreads();
            }
        }
    }

#undef P3_CONVERT
#undef P3_ITEM
    SEAM(3);
    PH_BEGIN(4)
        PHASE_IDS;
        {
            const bf16* Zt = PROJ + 3 * PROJ_T;
            const f32x4* nwp = (const f32x4*)(gdn_norm_w + 16 * (lane & 7)); const f32x4 n0 = nwp[0], n1 = nwp[1], n2 = nwp[2], n3 = nwp[3];
            v4u noa = (v4u){0u, 0u, 0u, 0u}, nob = noa, nza = noa, nzb = noa, n2oa = noa, n2ob = noa, n2za = noa, n2zb = noa;
            if (gw < T) { const v4u* yp0 = (const v4u*)(Y + (size_t)gw * D + 16 * lane); const v4u* zp0 = (const v4u*)(Zt + (size_t)gw * 1024 + 16 * lane); noa = yp0[0]; nob = yp0[1]; nza = zp0[0]; nzb = zp0[1]; }
            if (gw + NGW < T) { const v4u* yp0 = (const v4u*)(Y + (size_t)(gw + NGW) * D + 16 * lane); const v4u* zp0 = (const v4u*)(Zt + (size_t)(gw + NGW) * 1024 + 16 * lane); n2oa = yp0[0]; n2ob = yp0[1]; n2za = zp0[0]; n2zb = zp0[1]; }
            for (int t = gw; t < T; t += NGW) {
                v4u* yp = (v4u*)(Y + (size_t)t * D + 16 * lane);
                const v4u oa = noa, ob = nob, za = nza, zb = nzb;
                noa = n2oa; nob = n2ob; nza = n2za; nzb = n2zb;
                if (t + 2 * NGW < T) { const v4u* yp1 = (const v4u*)(Y + (size_t)(t + 2 * NGW) * D + 16 * lane); const v4u* zp1 = (const v4u*)(Zt + (size_t)(t + 2 * NGW) * 1024 + 16 * lane); n2oa = yp1[0]; n2ob = yp1[1]; n2za = zp1[0]; n2zb = zp1[1]; }
                float o[16] = {bflo(oa.x), bfhi(oa.x), bflo(oa.y), bfhi(oa.y), bflo(oa.z), bfhi(oa.z), bflo(oa.w), bfhi(oa.w), bflo(ob.x), bfhi(ob.x), bflo(ob.y), bfhi(ob.y), bflo(ob.z), bfhi(ob.z), bflo(ob.w), bfhi(ob.w)};
                const float z[16] = {bflo(za.x), bfhi(za.x), bflo(za.y), bfhi(za.y), bflo(za.z), bfhi(za.z), bflo(za.w), bfhi(za.w), bflo(zb.x), bfhi(zb.x), bflo(zb.y), bfhi(zb.y), bflo(zb.z), bfhi(zb.z), bflo(zb.w), bfhi(zb.w)};
                const float nwv[16] = {n0.x, n0.y, n0.z, n0.w, n1.x, n1.y, n1.z, n1.w, n2.x, n2.y, n2.z, n2.w, n3.x, n3.y, n3.z, n3.w};
                float ss = 0.f;
#pragma unroll
                for (int i = 0; i < 16; ++i) ss += o[i] * o[i];
                ss += __shfl_xor(ss, 1); ss += __shfl_xor(ss, 2); ss += __shfl_xor(ss, 4);
                const float rs = rsqrtf(ss * (1.f / 128.f) + EPS);
#pragma unroll
                for (int i = 0; i < 16; ++i) o[i] = o[i] * rs * nwv[i] * siluf(z[i]);
                v4u ya, yb; ya.x = cvtpk(o[0], o[1]); ya.y = cvtpk(o[2], o[3]); ya.z = cvtpk(o[4], o[5]); ya.w = cvtpk(o[6], o[7]); yb.x = cvtpk(o[8], o[9]); yb.y = cvtpk(o[10], o[11]); yb.z = cvtpk(o[12], o[13]); yb.w = cvtpk(o[14], o[15]);
                yp[0] = ya; yp[1] = yb;
            }
        }
        SEAM_ALWAYS;
        pg8::Gemm g{Y, WOUT, T, D, 1024, D}; pg8::StaticOrder S; S.init(T, D, G, (int)blockIdx.x);
        pg8::EpiRes2 E{(const bf16*)out, H1B, SSQ, D};
        pg8::gemm_phase<pg8::EpiRes2, pg8::StaticOrder, PG8_ALIGN, PG8_SP2>(lds + RING_OFF, g, S, E, wave);
    }

    SEAM(4);
    PH_BEGIN(5)
        PHASE_IDS;
        constexpr int BP = 264;
        LAS bf16* Bs0 = (LAS bf16*)lds; LAS bf16* Bs1 = (LAS bf16*)(lds + 43008);
        for (int wt = blockIdx.x; wt < T / 128; wt += G) {
            const int row0 = wt * 128 + wave * 16, fr = lane & 15, fg = lane >> 4;
            pg8::f32x4 acc[5];
#pragma unroll
            for (int n = 0; n < 5; ++n) acc[n] = (pg8::f32x4){0.f, 0.f, 0.f, 0.f};
            const bf16* ap = H1B + (size_t)(row0 + fr) * D + 8 * fg;
            v4u sb[5]; pg8::bf16x8 a[8], an[8];
#define P5_LOADB(s_) do { _Pragma("unroll") for (int i = 0; i < 5; ++i) { const int p_ = tid + NWAVES * 64 * i; sb[i] = *(const v4u*)(WR + (size_t)(p_ >> 5) * D + (s_) * 256 + (p_ & 31) * 8); } } while (0)
#define P5_PUTB(buf_) do { _Pragma("unroll") for (int i = 0; i < 5; ++i) { const int p_ = tid + NWAVES * 64 * i; *(LAS v4u*)((buf_) + (p_ >> 5) * BP + (p_ & 31) * 8) = sb[i]; } } while (0)
#define P5_LOADA(dst_, s_) do { _Pragma("unroll") for (int u = 0; u < 8; ++u) dst_[u] = *(const pg8::bf16x8*)(ap + (s_) * 256 + 32 * u); } while (0)
            P5_LOADB(0); P5_LOADA(an, 0); P5_PUTB(Bs0);
            asm volatile("s_waitcnt lgkmcnt(0)" ::: "memory"); __builtin_amdgcn_s_barrier(); asm volatile("" ::: "memory");
#pragma unroll 1
            for (int sl = 0; sl < 8; ++sl) {
                LAS bf16* cur = (sl & 1) ? Bs1 : Bs0; LAS bf16* nxt = (sl & 1) ? Bs0 : Bs1;
#pragma unroll
                for (int u = 0; u < 8; ++u) a[u] = an[u];
                if (sl + 1 < 8) { P5_LOADB(sl + 1); P5_LOADA(an, sl + 1); }
                const LAS bf16* bp = cur + fr * BP + 8 * fg;
#pragma unroll
                for (int u = 0; u < 8; ++u)
#pragma unroll
                    for (int n = 0; n < 5; ++n) { const pg8::bf16x8 bq = *(const LAS pg8::bf16x8*)(bp + (16 * n) * BP + 32 * u); acc[n] = __builtin_amdgcn_mfma_f32_16x16x32_bf16(a[u], bq, acc[n], 0, 0, 0); }
                if (sl + 1 < 8) P5_PUTB(nxt);
                asm volatile("s_waitcnt lgkmcnt(0)" ::: "memory"); __builtin_amdgcn_s_barrier(); asm volatile("" ::: "memory");
            }
#undef P5_LOADB
#undef P5_PUTB
#undef P5_LOADA
            LAS float* LG = (LAS float*)(lds + 86016) + wave * (16 * 84);
#pragma unroll
            for (int n = 0; n < 5; ++n)
#pragma unroll
                for (int r = 0; r < 4; ++r) LG[(4 * fg + r) * 84 + 16 * n + fr] = acc[n][r];
            float rsl;
            { const f32x4* sp = (const f32x4*)(SSQ + (size_t)(row0 + fr) * 32); f32x4 a4 = sp[0];
#pragma unroll
              for (int q = 1; q < 8; ++q) a4 += sp[q];
              rsl = rsqrtf(((a4.x + a4.y) + (a4.z + a4.w)) * (1.f / 2048.f) + EPS); }
            LDS_WAIT(); asm volatile("" ::: "memory");
            int mycnt = 0;
#pragma unroll 1
            for (int rr = 0; rr < 16; ++rr) {
                const int t = row0 + rr; const float rs = __shfl(rsl, rr);
                const float gl = LG[rr * 84 + (lane & 7)] * rs + rgb[lane & 7], el = LG[rr * 84 + 8 + lane] * rs + reb[lane];
                float gm = gl; gm = fmaxf(gm, __shfl_xor(gm, 1)); gm = fmaxf(gm, __shfl_xor(gm, 2)); gm = fmaxf(gm, __shfl_xor(gm, 4));
                int gi = (gl == gm) ? (lane & 7) : 8; gi = min(gi, __shfl_xor(gi, 1)); gi = min(gi, __shfl_xor(gi, 2)); gi = min(gi, __shfl_xor(gi, 4));
                float gsum = __expf(gl - gm); gsum += __shfl_xor(gsum, 1); gsum += __shfl_xor(gsum, 2); gsum += __shfl_xor(gsum, 4);
                gi = __builtin_amdgcn_readfirstlane(gi); const float gwt = 1.0f / gsum;
                const float v = __shfl(el, gi * 8 + (lane & 7));
                float m1 = v; m1 = fmaxf(m1, __shfl_xor(m1, 1)); m1 = fmaxf(m1, __shfl_xor(m1, 2)); m1 = fmaxf(m1, __shfl_xor(m1, 4));
                int i1 = (v == m1) ? (lane & 7) : 8; i1 = min(i1, __shfl_xor(i1, 1)); i1 = min(i1, __shfl_xor(i1, 2)); i1 = min(i1, __shfl_xor(i1, 4));
                const float v2 = ((lane & 7) == i1) ? -3.0e38f : v;
                float m2 = v2; m2 = fmaxf(m2, __shfl_xor(m2, 1)); m2 = fmaxf(m2, __shfl_xor(m2, 2)); m2 = fmaxf(m2, __shfl_xor(m2, 4));
                int i2 = (v2 == m2) ? (lane & 7) : 8; i2 = min(i2, __shfl_xor(i2, 1)); i2 = min(i2, __shfl_xor(i2, 2)); i2 = min(i2, __shfl_xor(i2, 4));
                const float e2 = __expf(m2 - m1), inv = 1.0f / (1.0f + e2);
                const int e_a = gi * 8 + __builtin_amdgcn_readfirstlane(i1), e_b = gi * 8 + __builtin_amdgcn_readfirstlane(i2);
                mycnt += (lane == e_a) + (lane == e_b);
                if (lane == 0) { EID[t * 2] = e_a; EID[t * 2 + 1] = e_b; GATE[t * 2] = gwt * inv; GATE[t * 2 + 1] = gwt * e2 * inv; RSTD[t] = rs; }
            }
            if (mycnt) atomicAdd(&CNT[(row0 >> 8) * 64 + lane], mycnt);
            LDS_WAIT(); asm volatile("" ::: "memory");
        }
    }

    SEAM(5);
    PH_BEGIN(6)
        PHASE_IDS;
        if (blockIdx.x < T / 256) {
            const int w = blockIdx.x;
            LAS int* ptot = (LAS int*)lds; LAS int* pbef = ptot + 512; LAS int* basel = pbef + 512; LAS int* eidl = basel + 64; LAS int* posl = eidl + 512; LAS int* totl = posl + 512; LAS int* startl = totl + 64;
            { const int e = tid & 63, part = tid >> 6; int st = 0, sb = 0;
              for (int q = 0; q < 16; ++q) { const int wp = part * 16 + q; const int cv = CNT[wp * 64 + e]; st += cv; sb += (wp < w) ? cv : 0; }
              ptot[part * 64 + e] = st; pbef[part * 64 + e] = sb; }
            eidl[tid] = EID[w * 512 + tid];
            __syncthreads();
            if (wave == 0) {
                int tot = 0, bef = 0;
#pragma unroll
                for (int p = 0; p < 8; ++p) { tot += ptot[p * 64 + lane]; bef += pbef[p * 64 + lane]; }
                const int pc = ((tot + 255) >> 8) << 8; int incl = pc;
#pragma unroll
                for (int o = 1; o < 64; o <<= 1) { const int v = __shfl_up(incl, o); if (lane >= o) incl += v; }
                const int start = incl - pc;
                basel[lane] = start + bef; totl[lane] = tot; startl[lane] = start;
                if (w == 0) { for (int r = 0; r < (pc >> 8); ++r) TILES[64 + (start >> 8) + r] = lane; if (lane == 63) TILES[0] = incl >> 8; }
            }
            LAS int* wcnt = startl + 64;
            wcnt[tid] = 0;
            __syncthreads();
            const int mye = eidl[tid]; int rk = 0;
#pragma unroll 8
            for (int l = 0; l < 64; ++l) { const int el = __builtin_amdgcn_readlane(mye, l); rk += (l < lane && el == mye) ? 1 : 0; }
            atomicAdd((int*)&wcnt[wave * 64 + mye], 1);
            __syncthreads();
            { int off = 0;
              for (int w2 = 0; w2 < wave; ++w2) off += wcnt[w2 * 64 + mye];
              const int a = w * 512 + tid; const int p = basel[mye] + off + rk; ROWTOK[p] = a >> 1; ROWGATE[p] = GATE[a]; ROWSC[p] = RSTD[a >> 1]; POS[a] = p; }
            if (w < NE) { const int e = w; const int s0 = startl[e] + totl[e], s1 = startl[e] + (((totl[e] + 255) >> 8) << 8);
                for (int p = s0 + tid; p < s1; p += NWAVES * 64) { ROWTOK[p] = 0; ROWGATE[p] = 0.f; ROWSC[p] = 0.f; } }
        }
    }

    PH_BEGIN(7)
    }

    SEAM(7);
    PH_BEGIN(8)
        PHASE_IDS;
        LAS int* rt = (LAS int*)(lds + RING_BYTES);
        LAS float* rsc = (LAS float*)(lds + RING_BYTES + 8192);
        LAS int* te = (LAS int*)(lds + RING_BYTES + 16384);
        const int ntl = TILES[0];
        for (int i = tid; i < ntl; i += NWAVES * 64) te[i] = TILES[64 + i];
        __syncthreads();
        pg8::Gemm g{H1B, WGU, CAP_ROWS, NE * 1024, D}; pg8::MoeOrder S{te, ntl, 4, G, (int)blockIdx.x, 48, 64};
        { pg8::Unit uu; for (int i = 0; i < 8 && S.next(i, uu); ++i) { if (tid < 256) rt[i * 256 + tid] = ROWTOK[uu.pm * 256 + tid]; else rsc[i * 256 + tid - 256] = ROWSC[uu.pm * 256 + tid - 256]; } }
        __syncthreads();
        pg8::EpiSwiGLU E{HID, rsc};
        pg8::gemm_phase<pg8::EpiSwiGLU, pg8::MoeOrder, PG8_ALIGN, PG8_SP2, true>(lds + RING_OFF, g, S, E, wave, rt);
    }
    SEAM(8);
    PH_BEGIN(9)
        PHASE_IDS;
        LAS float* rgt = (LAS float*)(lds + RING_BYTES);
        LAS int* te = (LAS int*)(lds + RING_BYTES + 16384);
        const int ntl = TILES[0];
        for (int i = tid; i < ntl; i += NWAVES * 64) te[i] = TILES[64 + i];
        __syncthreads();
        pg8::Gemm g{HID, WDN, CAP_ROWS, NE * 2048, DE}; pg8::MoeOrder S{te, ntl, 8, G, (int)blockIdx.x, 1 << 30, 0};
        { pg8::Unit uu; for (int i = 0; i < 12 && S.next(i, uu); ++i) { if (tid < 256) rgt[i * 256 + tid] = ROWGATE[uu.pm * 256 + tid]; } }
        __syncthreads();
        pg8::EpiDown E{YMOE, rgt};
        pg8::gemm_phase<pg8::EpiDown, pg8::MoeOrder, PG8_ALIGN, PG8_SP2>(lds + RING_OFF, g, S, E, wave);
    }
    SEAM(9);
    PH_BEGIN(10)
        PHASE_IDS;
        {
            v2u na[8], nb[8], nh[8]; int q0 = 0, q1 = 0;
            f32x4 fwv[8];
#pragma unroll
            for (int j = 0; j < 8; ++j) fwv[j] = *((const f32x4*)final_w + lane + 64 * j);
#define P10_LOAD(tt, p0_, p1_) do { const v2u* hb_ = (const v2u*)(H1B + (size_t)(tt) * D) + lane; const v2u* y0_ = (const v2u*)(YMOE + (size_t)(p0_) * D) + lane; const v2u* y1_ = (const v2u*)(YMOE + (size_t)(p1_) * D) + lane; \
        _Pragma("unroll") for (int j = 0; j < 8; ++j) { na[j] = y0_[64 * j]; nb[j] = y1_[64 * j]; nh[j] = hb_[64 * j]; } } while (0)
            if (gw < T) { P10_LOAD(gw, POS[gw * 2], POS[gw * 2 + 1]); }
            if (gw + NGW < T) { q0 = POS[(gw + NGW) * 2]; q1 = POS[(gw + NGW) * 2 + 1]; }
            for (int t = gw; t < T; t += NGW) {
                f32x4 v[8]; float ss = 0.f;
#pragma unroll
                for (int j = 0; j < 8; ++j) { const v2u a = na[j], b = nb[j], hh = nh[j];
                    v[j].x = bflo(hh.x) + (bflo(a.x) + bflo(b.x)); v[j].y = bfhi(hh.x) + (bfhi(a.x) + bfhi(b.x)); v[j].z = bflo(hh.y) + (bflo(a.y) + bflo(b.y)); v[j].w = bfhi(hh.y) + (bfhi(a.y) + bfhi(b.y));
                    ss += (v[j].x * v[j].x + v[j].y * v[j].y) + (v[j].z * v[j].z + v[j].w * v[j].w); }
                if (t + NGW < T) { P10_LOAD(t + NGW, q0, q1); }
                if (t + 2 * NGW < T) { q0 = POS[(t + 2 * NGW) * 2]; q1 = POS[(t + 2 * NGW) * 2 + 1]; }
                const float rstd = rsqrtf(wave_sum(ss) * (1.f / D) + EPS);
                f32x4* hr = (f32x4*)(out + (size_t)t * D) + lane;
#pragma unroll
                for (int j = 0; j < 8; ++j) hr[64 * j] = v[j] * rstd * fwv[j];
            }
#undef P10_LOAD
        }
    }
#undef IN
#undef SEAM
}

template <unsigned PM> static bool setup_kernel(int& per_cu) {
    if (hipFuncSetAttribute((const void*)fwd<PM>, hipFuncAttributeMaxDynamicSharedMemorySize, LDS_BYTES) != hipSuccess) return false;
    int pc = 0; if (hipOccupancyMaxActiveBlocksPerMultiprocessor(&pc, (const void*)fwd<PM>, NWAVES * 64, LDS_BYTES) != hipSuccess) pc = 0;
    per_cu = pc; (void)hipGetLastError(); return true;
}
template <unsigned PM> static void launch_phase(int grid, hipStream_t stream, Args a, int ph) { a.ph_lo = ph; a.ph_hi = ph + 1; hipLaunchKernelGGL(fwd<PM>, dim3(grid), dim3(NWAVES * 64), LDS_BYTES, stream, a); }
extern "C" void kernel_launch(void* const* d_in, const int* in_sizes, int n_in, void* d_out, int out_size, void* d_ws, size_t ws_size, hipStream_t stream) {
    static int grid = 0;
    if (grid == 0) {
        if (n_in != 18 || in_sizes[0] != T * D || out_size != T * D || ws_size < WS_END) { fprintf(stderr, "kernel_launch: unexpected shapes (n_in %d, in0 %d, out %d, ws %zu); nothing launched\n", n_in, n_in > 0 ? in_sizes[0] : -1, out_size, ws_size); grid = -1; return; }
        int dev = 0, cus = 0, per_cu = 0;
        if (hipGetDevice(&dev) != hipSuccess || hipDeviceGetAttribute(&cus, hipDeviceAttributeMultiprocessorCount, dev) != hipSuccess) { grid = -1; return; }
        bool ok = setup_kernel<0x7FFu>(per_cu);
        if (!ok) { fprintf(stderr, "kernel_launch: hipFuncSetAttribute failed\n"); grid = -1; return; }
        grid = cus;
    }
    if (grid < 0) return;
    if (hipMemsetAsync((char*)d_ws + WS_CTL, 0, CTL_ZERO_BYTES, stream) != hipSuccess) return;
    Args a{};
    for (int i = 0; i < 18; ++i) a.in[i] = (const float*)d_in[i];
    a.out = (float*)d_out; a.ws = (unsigned char*)d_ws;
    a.ph_lo = 0; a.ph_hi = N_PHASES;
    hipLaunchKernelGGL(fwd<0x7FFu>, dim3(grid), dim3(NWAVES * 64), LDS_BYTES, stream, a);
}
```

```cpp
#include <hip/hip_runtime.h>
#include <cstdio>
#include <cstdint>
__device__ __forceinline__ int lane_id_v() { int l; asm volatile("v_mbcnt_lo_u32_b32 %0, -1, 0\n\tv_mbcnt_hi_u32_b32 %0, -1, %0" : "=v"(l)); return l; }
namespace pg8 {
#define PG8_LAS __attribute__((address_space(3)))
typedef unsigned short bf16_t;
typedef short bf16x8 __attribute__((ext_vector_type(8)));
typedef float f32x4 __attribute__((ext_vector_type(4)));
typedef unsigned u32x4 __attribute__((ext_vector_type(4)));
constexpr int BM = 256, BK = 64, HALF = 128, HTB = HALF * BK * 2  , STAGE_BYTES = 8 * HTB, NXCD = 8, WGM = 8;

__host__ __device__ __forceinline__ int lds_byte(int r, int c) { const int st = (r >> 4) * 2 + (c >> 5), rr = r & 15, cc = c & 31, ob = rr * 64 + cc * 2; return st * 1024 + (ob ^ (((ob >> 9) & 1) << 5)); }
__host__ __device__ __forceinline__ void stage_rc(int b, int& R, int& C) { const int st = b / 1024, sb = b % 1024, swz = sb ^ (((sb >> 9) & 1) << 5); R = (st >> 1) * 16 + swz / 64; C = (st & 1) * 32 + (swz % 64) / 2; }
__host__ __device__ __forceinline__ int perm32(int rho) { const int n = rho >> 4, i = rho & 15; return 8 * (i >> 2) + 4 * n + (i & 3); }

struct Unit { int pm, pn, li; };
struct Gemm { const bf16_t* A; const bf16_t* Bt; int M, N, K; int ld; };

struct StaticOrder {
    int nM, nN, nwg, G, c;
    __host__ __device__ void init(int M, int N, int G_, int c_) { nM = M / BM; nN = N / BM; nwg = nM * nN; G = G_; c = c_; }
    __host__ __device__ bool next(int i, Unit& u) const {
        const long L = (long)i * G + c; if (L >= nwg) return false;
        int wgid = (int)L; { const int q = nwg / NXCD, r = nwg % NXCD, xcd = wgid % NXCD, off = wgid / NXCD; wgid = (xcd < r ? xcd * (q + 1) : r * (q + 1) + (xcd - r) * q) + off; }
        const int nig = WGM * nN, gid = wgid / nig, fm = gid * WGM, gsz = (nM - fm) < WGM ? (nM - fm) : WGM;
        u.pm = fm + ((wgid % nig) % gsz); u.pn = (wgid % nig) / gsz; return true;
    }
    __device__ __forceinline__ void a_ready(const Unit&) const {}
    __device__ __forceinline__ void done(const Unit&) const {}
};

__device__ __forceinline__ unsigned cvt_pk_bf16(float lo, float hi) { unsigned r; asm volatile("v_cvt_pk_bf16_f32 %0, %1, %2" : "=v"(r) : "v"(lo), "v"(hi)); return r; }
typedef float f32x2 __attribute__((ext_vector_type(2)));
struct EpiBf16S {
    static constexpr bool PERM = true, AFTER_DRAIN = false; static constexpr bool LINE = true;
    bf16_t* O; int ldc; int split_cols; size_t split_stride;
    __device__ __forceinline__ void operator()(const f32x4 (&acc)[2][2][4][2], const Unit& u, int wr, int wc, int fr, int fq) const {
        const bool lo = fr < 8;
        const int row0 = u.pm * BM + wr * 64 + (fr & 7); int colt = u.pn * BM; bf16_t* base = O;
        if (split_cols) { const int t = colt / split_cols; base += (size_t)t * split_stride; colt -= t * split_cols; }
        const int col0 = colt + wc * 64 + (fr >> 3) * 32 + 8 * fq;
#pragma unroll
        for (int ai = 0; ai < 2; ++ai)
#pragma unroll
            for (int m = 0; m < 4; ++m) { bf16_t* rowp = base + (size_t)(row0 + ai * HALF + m * 16) * ldc + col0;
                u32x4 w0, w1, A, B;
                { const f32x4 v0 = acc[ai][0][m][0], v1 = acc[ai][0][m][1]; w0.x = cvt_pk_bf16(v0[0], v0[1]); w0.y = cvt_pk_bf16(v0[2], v0[3]); w0.z = cvt_pk_bf16(v1[0], v1[1]); w0.w = cvt_pk_bf16(v1[2], v1[3]); }
                { const f32x4 v0 = acc[ai][1][m][0], v1 = acc[ai][1][m][1]; w1.x = cvt_pk_bf16(v0[0], v0[1]); w1.y = cvt_pk_bf16(v0[2], v0[3]); w1.z = cvt_pk_bf16(v1[0], v1[1]); w1.w = cvt_pk_bf16(v1[2], v1[3]); }
#pragma unroll
                for (int j = 0; j < 4; ++j) { const unsigned give = lo ? w1[j] : w0[j];
                    const unsigned recv = (unsigned)__builtin_amdgcn_update_dpp(0, (int)give, 0x128  , 0xf, 0xf, false);
                    A[j] = lo ? w0[j] : recv; B[j] = lo ? recv : w1[j]; }
                *(u32x4*)rowp = A; *(u32x4*)(rowp + (size_t)8 * ldc) = B; }
    }
};
struct EpiResF32 {
    static constexpr bool PERM = false, AFTER_DRAIN = false; static constexpr bool LINE = false;
    const float* base; float* C; int ldc;
    __device__ __forceinline__ void operator()(const f32x4 (&acc)[2][2][4][2], const Unit& u, int wr, int wc, int fr, int fq) const {
        const int row0 = u.pm * BM + wr * 64 + fr, col0 = u.pn * BM + wc * 32 + 4 * fq;
#pragma unroll
        for (int ai = 0; ai < 2; ++ai) { constexpr int m0 = 0;
            f32x4 bv[4][2][2];
#pragma unroll
            for (int m = m0; m < m0 + 4; ++m) { const size_t off = (size_t)(row0 + ai * HALF + m * 16) * ldc + col0;
#pragma unroll
                for (int bj = 0; bj < 2; ++bj)
#pragma unroll
                    for (int n = 0; n < 2; ++n) bv[m][bj][n] = *(const f32x4*)(base + off + bj * HALF + n * 16); }
#pragma unroll
            for (int m = m0; m < m0 + 4; ++m) { const size_t off = (size_t)(row0 + ai * HALF + m * 16) * ldc + col0;
#pragma unroll
                for (int bj = 0; bj < 2; ++bj)
#pragma unroll
                    for (int n = 0; n < 2; ++n) *(f32x4*)(C + off + bj * HALF + n * 16) = bv[m][bj][n] + acc[ai][bj][m][n]; }
        }
    }
};
__device__ __forceinline__ float silu_f(float x) { return x * __builtin_amdgcn_rcpf(1.0f + __expf(-x)); }
struct EpiSwiGLU {
    static constexpr bool PERM = true, AFTER_DRAIN = false; static constexpr bool LINE = false;
    bf16_t* H; const PG8_LAS float* rowsc;
    __device__ __forceinline__ void operator()(const f32x4 (&acc)[2][2][4][2], const Unit& u, int wr, int wc, int fr, int fq) const {
        const int row0 = u.pm * BM + wr * 64 + fr, col0 = (u.pn & 3) * 128 + wc * 32 + 8 * fq;
        float scv[2][4];
#pragma unroll
        for (int ai = 0; ai < 2; ++ai)
#pragma unroll
            for (int m = 0; m < 4; ++m) scv[ai][m] = rowsc[u.li * BM + wr * 64 + fr + ai * HALF + m * 16];
#pragma unroll
        for (int ai = 0; ai < 2; ++ai)
#pragma unroll
            for (int m = 0; m < 4; ++m) { bf16_t* rowp = H + (size_t)(row0 + ai * HALF + m * 16) * 512 + col0; const float sc = scv[ai][m];
                const f32x4 g0 = acc[ai][0][m][0] * sc, g1 = acc[ai][0][m][1] * sc, u0 = acc[ai][1][m][0] * sc, u1 = acc[ai][1][m][1] * sc;
                f32x4 h0, h1;
#pragma unroll
                for (int j = 0; j < 4; ++j) { h0[j] = silu_f(g0[j]) * u0[j]; h1[j] = silu_f(g1[j]) * u1[j]; }
                u32x4 w; w.x = cvt_pk_bf16(h0[0], h0[1]); w.y = cvt_pk_bf16(h0[2], h0[3]); w.z = cvt_pk_bf16(h1[0], h1[1]); w.w = cvt_pk_bf16(h1[2], h1[3]);
                *(u32x4*)rowp = w; }
    }
};
struct EpiDown {
    static constexpr bool PERM = true, AFTER_DRAIN = false; static constexpr bool LINE = true;
    bf16_t* Y; const PG8_LAS float* rowgate;
    __device__ __forceinline__ void operator()(const f32x4 (&acc)[2][2][4][2], const Unit& u, int wr, int wc, int fr, int fq) const {
        const bool lo = fr < 8;
        const int row0 = u.pm * BM + wr * 64 + (fr & 7), col0 = (u.pn & 7) * 256 + wc * 64 + (fr >> 3) * 32 + 8 * fq;
        float gtv[2][4];
#pragma unroll
        for (int ai = 0; ai < 2; ++ai)
#pragma unroll
            for (int m = 0; m < 4; ++m) gtv[ai][m] = rowgate[u.li * BM + wr * 64 + fr + ai * HALF + m * 16];
#pragma unroll
        for (int ai = 0; ai < 2; ++ai)
#pragma unroll
            for (int m = 0; m < 4; ++m) { const float gt = gtv[ai][m]; bf16_t* rowp = Y + (size_t)(row0 + ai * HALF + m * 16) * 2048 + col0;
                u32x4 w0, w1, A, B;
                { const f32x4 v0 = acc[ai][0][m][0] * gt, v1 = acc[ai][0][m][1] * gt; w0.x = cvt_pk_bf16(v0[0], v0[1]); w0.y = cvt_pk_bf16(v0[2], v0[3]); w0.z = cvt_pk_bf16(v1[0], v1[1]); w0.w = cvt_pk_bf16(v1[2], v1[3]); }
                { const f32x4 v0 = acc[ai][1][m][0] * gt, v1 = acc[ai][1][m][1] * gt; w1.x = cvt_pk_bf16(v0[0], v0[1]); w1.y = cvt_pk_bf16(v0[2], v0[3]); w1.z = cvt_pk_bf16(v1[0], v1[1]); w1.w = cvt_pk_bf16(v1[2], v1[3]); }
#pragma unroll
                for (int j = 0; j < 4; ++j) { const unsigned give = lo ? w1[j] : w0[j];
                    const unsigned recv = (unsigned)__builtin_amdgcn_update_dpp(0, (int)give, 0x128  , 0xf, 0xf, false);
                    A[j] = lo ? w0[j] : recv; B[j] = lo ? recv : w1[j]; }
                *(u32x4*)rowp = A; *(u32x4*)(rowp + (size_t)8 * 2048) = B; }
    }
};
struct EpiResB16 {
    static constexpr bool PERM = true, AFTER_DRAIN = false; static constexpr bool LINE = false;
    const float* base; bf16_t* C; int ldc;
    __device__ __forceinline__ void operator()(const f32x4 (&acc)[2][2][4][2], const Unit& u, int wr, int wc, int fr, int fq) const {
        const int row0 = u.pm * BM + wr * 64 + fr, col0 = u.pn * BM + wc * 32 + 8 * fq;
#pragma unroll
        for (int ai = 0; ai < 2; ++ai) {
            f32x4 bv[4][2][2];
#pragma unroll
            for (int m = 0; m < 4; ++m) { const size_t off = (size_t)(row0 + ai * HALF + m * 16) * ldc + col0;
#pragma unroll
                for (int bj = 0; bj < 2; ++bj)
#pragma unroll
                    for (int n = 0; n < 2; ++n) bv[m][bj][n] = *(const f32x4*)(base + off + bj * HALF + n * 4); }
#pragma unroll
            for (int m = 0; m < 4; ++m) { const size_t off = (size_t)(row0 + ai * HALF + m * 16) * ldc + col0;
#pragma unroll
                for (int bj = 0; bj < 2; ++bj) { const f32x4 v0 = bv[m][bj][0] + acc[ai][bj][m][0], v1 = bv[m][bj][1] + acc[ai][bj][m][1];
                    u32x4 w; w.x = cvt_pk_bf16(v0[0], v0[1]); w.y = cvt_pk_bf16(v0[2], v0[3]); w.z = cvt_pk_bf16(v1[0], v1[1]); w.w = cvt_pk_bf16(v1[2], v1[3]);
                    *(u32x4*)(C + off + bj * HALF) = w; } }
        }
    }
};
struct EpiRes2 {
    static constexpr bool PERM = true, AFTER_DRAIN = false; static constexpr bool LINE = false;
    const bf16_t* base; bf16_t* Hb; float* ssq; int ldc;
    __device__ __forceinline__ void operator()(const f32x4 (&acc)[2][2][4][2], const Unit& u, int wr, int wc, int fr, int fq) const {
        const int row0 = u.pm * BM + wr * 64 + fr, col0 = u.pn * BM + wc * 32 + 8 * fq;
#pragma unroll
        for (int ai = 0; ai < 2; ++ai) {
            u32x4 bb[4][2];
#pragma unroll
            for (int m = 0; m < 4; ++m) { const size_t off = (size_t)(row0 + ai * HALF + m * 16) * ldc + col0;
#pragma unroll
                for (int bj = 0; bj < 2; ++bj) bb[m][bj] = *(const u32x4*)(base + off + bj * HALF); }
#pragma unroll
            for (int m = 0; m < 4; ++m) { const int row = row0 + ai * HALF + m * 16; const size_t off = (size_t)row * ldc + col0; float s = 0.f;
#pragma unroll
                for (int bj = 0; bj < 2; ++bj) { const u32x4 b = bb[m][bj]; f32x4 h0 = acc[ai][bj][m][0], h1 = acc[ai][bj][m][1];
                    h0[0] += __uint_as_float(b.x << 16); h0[1] += __uint_as_float(b.x & 0xffff0000u); h0[2] += __uint_as_float(b.y << 16); h0[3] += __uint_as_float(b.y & 0xffff0000u);
                    h1[0] += __uint_as_float(b.z << 16); h1[1] += __uint_as_float(b.z & 0xffff0000u); h1[2] += __uint_as_float(b.w << 16); h1[3] += __uint_as_float(b.w & 0xffff0000u);
                    s += ((h0[0] * h0[0] + h0[1] * h0[1]) + (h0[2] * h0[2] + h0[3] * h0[3])) + ((h1[0] * h1[0] + h1[1] * h1[1]) + (h1[2] * h1[2] + h1[3] * h1[3]));
                    u32x4 w; w.x = cvt_pk_bf16(h0[0], h0[1]); w.y = cvt_pk_bf16(h0[2], h0[3]); w.z = cvt_pk_bf16(h1[0], h1[1]); w.w = cvt_pk_bf16(h1[2], h1[3]);
                    *(u32x4*)(Hb + off + bj * HALF) = w; }
                s += __shfl_xor(s, 16); s += __shfl_xor(s, 32);
                if (fq == 0) ssq[(size_t)row * 32 + u.pn * 4 + wc] = s; }
        }
    }
};
struct EpiRouter {
    static constexpr bool PERM = false, AFTER_DRAIN = true; static constexpr bool LINE = false;
    const float* ssq; const float* rgb; const float* reb; int* eid; float* gate; float* rstd_out; int* cnt;
    __device__ __forceinline__ void fused(f32x4 (&acc)[2][2][4][2], const Unit& u, int wr, int wc, int fr, int fq, PG8_LAS unsigned char* lds, int wid, int lane) const {
        PG8_LAS float* LG = (PG8_LAS float*)lds;
        PG8_LAS int* hc = (PG8_LAS int*)(lds + 256 * 76 * 4);
        if (wid == 0) hc[lane] = 0;
        if (wc < 3) {
#pragma unroll
            for (int ai = 0; ai < 2; ++ai)
#pragma unroll
                for (int m = 0; m < 4; ++m) { const int row = ai * HALF + wr * 64 + m * 16 + fr;
#pragma unroll
                    for (int n = 0; n < 2; ++n) { const int c0 = 32 * wc + 16 * n + 4 * fq; if (c0 < 72) *(PG8_LAS f32x4*)(LG + row * 76 + c0) = acc[ai][0][m][n]; } }
        }
        asm volatile("s_waitcnt lgkmcnt(0)" ::: "memory"); __builtin_amdgcn_s_barrier(); asm volatile("" ::: "memory");
        int mycnt = 0;
        float rsl;
        { const f32x4* sp = (const f32x4*)(ssq + (size_t)(u.pm * BM + wid * 32 + (lane & 31)) * 32); f32x4 a = sp[0];
#pragma unroll
          for (int q = 1; q < 8; ++q) a += sp[q];
          rsl = rsqrtf(((a.x + a.y) + (a.z + a.w)) * (1.f / 2048.f) + 1e-6f); }
#pragma unroll 1
        for (int rr = 0; rr < 32; ++rr) {
            const int row = wid * 32 + rr, t = u.pm * BM + row;
            const float rs = __shfl(rsl, rr);
            const float gl = LG[row * 76 + (lane & 7)] * rs + rgb[lane & 7], el = LG[row * 76 + 8 + lane] * rs + reb[lane];
            float gm = gl; gm = fmaxf(gm, __shfl_xor(gm, 1)); gm = fmaxf(gm, __shfl_xor(gm, 2)); gm = fmaxf(gm, __shfl_xor(gm, 4));
            int gi = (gl == gm) ? (lane & 7) : 8; gi = min(gi, __shfl_xor(gi, 1)); gi = min(gi, __shfl_xor(gi, 2)); gi = min(gi, __shfl_xor(gi, 4));
            float gsum = __expf(gl - gm); gsum += __shfl_xor(gsum, 1); gsum += __shfl_xor(gsum, 2); gsum += __shfl_xor(gsum, 4);
            gi = __builtin_amdgcn_readfirstlane(gi); const float gwt = 1.0f / gsum;
            const float v = __shfl(el, gi * 8 + (lane & 7));
            float m1 = v; m1 = fmaxf(m1, __shfl_xor(m1, 1)); m1 = fmaxf(m1, __shfl_xor(m1, 2)); m1 = fmaxf(m1, __shfl_xor(m1, 4));
            int i1 = (v == m1) ? (lane & 7) : 8; i1 = min(i1, __shfl_xor(i1, 1)); i1 = min(i1, __shfl_xor(i1, 2)); i1 = min(i1, __shfl_xor(i1, 4));
            const float v2 = ((lane & 7) == i1) ? -3.0e38f : v;
            float m2 = v2; m2 = fmaxf(m2, __shfl_xor(m2, 1)); m2 = fmaxf(m2, __shfl_xor(m2, 2)); m2 = fmaxf(m2, __shfl_xor(m2, 4));
            int i2 = (v2 == m2) ? (lane & 7) : 8; i2 = min(i2, __shfl_xor(i2, 1)); i2 = min(i2, __shfl_xor(i2, 2)); i2 = min(i2, __shfl_xor(i2, 4));
            const float e2 = __expf(m2 - m1), inv = 1.0f / (1.0f + e2);
            const int e_a = gi * 8 + __builtin_amdgcn_readfirstlane(i1), e_b = gi * 8 + __builtin_amdgcn_readfirstlane(i2);
            mycnt += (lane == e_a) + (lane == e_b);
            if (lane == 0) { eid[t * 2] = e_a; eid[t * 2 + 1] = e_b; gate[t * 2] = gwt * inv; gate[t * 2 + 1] = gwt * e2 * inv; rstd_out[t] = rs; }
        }
        atomicAdd((int*)&hc[lane], mycnt);
        asm volatile("s_waitcnt lgkmcnt(0)" ::: "memory"); __builtin_amdgcn_s_barrier(); asm volatile("" ::: "memory");
        if (wid == 0) cnt[u.pm * 64 + lane] = hc[lane];
    }
};
struct MoeOrder {
    const PG8_LAS int* tile_e; int ntiles, NT, G, c, skip_e, skip_tiles;
    __device__ __forceinline__ bool next(int i, Unit& u) const {
        int r, nt;
        if ((G & 7) == 0) { const int x = c & 7, rank = c >> 3, W = G >> 3; const int t0 = (int)((long)ntiles * x / 8), t1 = (int)((long)ntiles * (x + 1) / 8);
            const int j = i * W + rank; if (j >= (t1 - t0) * NT) return false; r = t0 + j / NT; nt = j % NT; }
        else { const long L = (long)i * G + c; if (L >= (long)ntiles * NT) return false; r = (int)(L / NT); nt = (int)(L % NT); }
        const int e = __builtin_amdgcn_readfirstlane(tile_e[r]); u.pm = r; u.pn = e * NT + nt + (e >= skip_e ? skip_tiles : 0); u.li = i; return true;
    }
    __device__ __forceinline__ void a_ready(const Unit&) const {}
    __device__ __forceinline__ void done(const Unit&) const {}
};
template <class Epi, class Sched, bool ALIGN_EPI = false, bool SP2 = false, bool GATHER = false>
__device__ __forceinline__ void gemm_phase(PG8_LAS unsigned char* lds, const Gemm g, const Sched& S, const Epi& E, const int wid, const PG8_LAS int* rowidx = nullptr) {
    const int lane = lane_id_v(), tid = wid * 64 + lane, wr = wid >> 2, wc = wid & 3, fr = lane & 15, fq = lane >> 4;
    const int K = g.K, nt = K / BK, LD = g.ld ? g.ld : g.K;
    unsigned voffA[2], voffB[2];
#pragma unroll
    for (int i = 0; i < 2; ++i) { int R, C; stage_rc(tid * 16 + i * 8192, R, C); const int Rb = Epi::PERM ? ((Epi::LINE ? 2 : 1) * (R & ~31) + perm32(R & 31)) : R;
        voffA[i] = (unsigned)(R * LD + C) * 2u; voffB[i] = (unsigned)(Rb * LD + C) * 2u; }
    int gR[2], gC[2];
#pragma unroll
    for (int i = 0; i < 2; ++i) stage_rc(tid * 16 + i * 8192, gR[i], gC[i]);
    unsigned offC[2][2], offN[2][2];
    const size_t kstep = (size_t)(BK * 2);
    const size_t hstep = (size_t)HALF * LD * 2; const size_t hstepA = GATHER ? 0 : hstep;
    const size_t hstepB = Epi::LINE ? (size_t)32 * LD * 2 : hstep;
    const size_t tstep = 2 * hstep;
    const unsigned ldsw = (unsigned)wid * 1024u;
    const int aoff = lds_byte(wr * 64 + fr, fq * 8), boff = lds_byte(wc * 32 + fr, fq * 8);
#define PG8_SA(b, h) (((b) * 2 + (h)) * HTB)
#define PG8_SB(b, h) ((4 + (b) * 2 + (h)) * HTB)
#define PG8_STAGE(bufoff, gbase, voff) do { _Pragma("unroll") for (int _i = 0; _i < 2; ++_i) \
        __builtin_amdgcn_global_load_lds((const unsigned*)((const char*)(gbase) + (voff)[_i]), (PG8_LAS unsigned*)(lds + (bufoff) + ldsw + _i * 8192), 16, 0, 0); } while (0)
#define PG8_LDA(dst, b, h) do { _Pragma("unroll") for (int m = 0; m < 4; ++m) _Pragma("unroll") for (int k = 0; k < 2; ++k) dst[m][k] = *(const PG8_LAS bf16x8*)(lds + PG8_SA(b, h) + aoff + m * 2048 + k * 1024); } while (0)
#define PG8_LDB(dst, b, h) do { _Pragma("unroll") for (int n = 0; n < 2; ++n) _Pragma("unroll") for (int k = 0; k < 2; ++k) dst[n][k] = *(const PG8_LAS bf16x8*)(lds + PG8_SB(b, h) + boff + n * 2048 + k * 1024); } while (0)
#define PG8_MMA(ai, bj, At, Bt) do { __builtin_amdgcn_s_setprio(1); _Pragma("unroll") for (int m = 0; m < 4; ++m) _Pragma("unroll") for (int n = 0; n < 2; ++n) _Pragma("unroll") for (int k = 0; k < 2; ++k) \
        acc[ai][bj][m][n] = __builtin_amdgcn_mfma_f32_16x16x32_bf16(Bt[n][k], At[m][k], acc[ai][bj][m][n], 0, 0, 0); __builtin_amdgcn_s_setprio(0); } while (0)
#define PG8_WAIT_V(n) asm volatile("s_waitcnt vmcnt(" #n ")" ::: "memory")
#define PG8_WAIT_L(n) asm volatile("s_waitcnt lgkmcnt(" #n ")" ::: "memory")
#define PG8_BAR __builtin_amdgcn_s_barrier()
#define PG8_SCHED __builtin_amdgcn_sched_barrier(0)
    Unit cur, nxt; int ui = 0;
    if (!S.next(0, cur)) return;
    f32x4 acc[2][2][4][2];
#pragma unroll
    for (int a = 0; a < 2; ++a)
#pragma unroll
        for (int b = 0; b < 2; ++b)
#pragma unroll
            for (int m = 0; m < 4; ++m)
#pragma unroll
                for (int n = 0; n < 2; ++n) acc[a][b][m][n] = (f32x4){0.f, 0.f, 0.f, 0.f};
    bf16x8 At[4][2], B0[2][2], B1[2][2];
    const char* cA = GATHER ? (const char*)g.A : (const char*)g.A + (size_t)cur.pm * tstep; const char* cB = (const char*)g.Bt + (size_t)cur.pn * tstep;
#pragma unroll
    for (int h = 0; h < 2; ++h)
#pragma unroll
        for (int i = 0; i < 2; ++i) { offC[h][i] = GATHER ? (unsigned)rowidx[h * HALF + gR[i]] * (unsigned)(LD * 2) + (unsigned)(gC[i] * 2) : voffA[i]; offN[h][i] = offC[h][i]; }
    S.a_ready(cur);
    if constexpr (SP2) {
        PG8_STAGE(PG8_SB(0, 0), cB, voffB); PG8_STAGE(PG8_SB(0, 1), cB + hstepB, voffB); PG8_STAGE(PG8_SA(0, 0), cA, offC[0]); PG8_STAGE(PG8_SA(0, 1), cA + hstepA, offC[1]);
        if (wr == 1) PG8_BAR;
        PG8_WAIT_V(2); PG8_BAR;
        PG8_STAGE(PG8_SB(1, 0), cB + kstep, voffB); PG8_STAGE(PG8_SA(1, 0), cA + kstep, offC[0]); PG8_STAGE(PG8_SB(1, 1), cB + hstepB + kstep, voffB);
        PG8_WAIT_V(6); PG8_BAR;
    } else {
        PG8_STAGE(PG8_SB(0, 0), cB, voffB); PG8_STAGE(PG8_SA(0, 0), cA, offC[0]); PG8_STAGE(PG8_SB(0, 1), cB + hstepB, voffB); PG8_STAGE(PG8_SA(0, 1), cA + hstepA, offC[1]);
        if (wr == 1) PG8_BAR;
        PG8_WAIT_V(4); PG8_BAR;
        PG8_STAGE(PG8_SB(1, 0), cB + kstep, voffB); PG8_STAGE(PG8_SA(1, 0), cA + kstep, offC[0]); PG8_STAGE(PG8_SB(1, 1), cB + hstepB + kstep, voffB);
        PG8_WAIT_V(6); PG8_BAR;
    }
    for (;;) {
        const bool has_next = S.next(ui + 1, nxt);
        const char* nA = (has_next && !GATHER) ? (const char*)g.A + (size_t)nxt.pm * tstep : cA;
        if (GATHER && has_next) {
#pragma unroll
            for (int h = 0; h < 2; ++h)
#pragma unroll
                for (int i = 0; i < 2; ++i) offN[h][i] = (unsigned)rowidx[(ui + 1) * BM + h * HALF + gR[i]] * (unsigned)(LD * 2) + (unsigned)(gC[i] * 2);
        } const char* nB = has_next ? (const char*)g.Bt + (size_t)nxt.pn * tstep : cB;
        for (int t = 0; t < nt; t += 2) {
            const bool last = (t == nt - 2);
            const char* a1 = cA + (size_t)(t + 1) * kstep;
            const char* a2 = last ? nA : cA + (size_t)(t + 2) * kstep; const char* b2 = last ? nB : cB + (size_t)(t + 2) * kstep;
            const char* a3 = a2 + kstep; const char* b3 = b2 + kstep;
            unsigned o2[2][2];
#pragma unroll
            for (int h = 0; h < 2; ++h)
#pragma unroll
                for (int i = 0; i < 2; ++i) o2[h][i] = last ? offN[h][i] : offC[h][i];
            if (last && has_next) S.a_ready(nxt);
            if constexpr (SP2) {
            PG8_LDB(B0, 0, 0); PG8_LDB(B1, 0, 1); PG8_SCHED; PG8_LDA(At, 0, 0); PG8_STAGE(PG8_SA(1, 1), a1 + hstepA, offC[1]);
            PG8_WAIT_V(8); PG8_WAIT_L(0); PG8_BAR; PG8_MMA(0, 0, At, B0); PG8_MMA(0, 1, At, B1); PG8_BAR; PG8_SCHED;
            PG8_LDA(At, 0, 1); PG8_STAGE(PG8_SB(0, 0), b2, voffB); PG8_STAGE(PG8_SB(0, 1), b2 + hstepB, voffB); PG8_STAGE(PG8_SA(0, 0), a2, o2[0]);
            PG8_WAIT_V(8); PG8_WAIT_L(0); PG8_BAR; PG8_MMA(1, 0, At, B0); PG8_MMA(1, 1, At, B1); PG8_BAR; PG8_SCHED;
            PG8_LDB(B0, 1, 0); PG8_LDB(B1, 1, 1); PG8_SCHED; PG8_LDA(At, 1, 0); PG8_STAGE(PG8_SA(0, 1), a2 + hstepA, o2[1]);
            PG8_WAIT_V(8); PG8_WAIT_L(0); PG8_BAR; PG8_MMA(0, 0, At, B0); PG8_MMA(0, 1, At, B1); PG8_BAR; PG8_SCHED;
            PG8_LDA(At, 1, 1); PG8_STAGE(PG8_SB(1, 0), b3, voffB); PG8_STAGE(PG8_SB(1, 1), b3 + hstepB, voffB); PG8_STAGE(PG8_SA(1, 0), a3, o2[0]);
            PG8_WAIT_V(8); PG8_WAIT_L(0); PG8_BAR; PG8_MMA(1, 0, At, B0); PG8_MMA(1, 1, At, B1); PG8_BAR; PG8_SCHED;
            } else {
            PG8_LDB(B0, 0, 0); PG8_SCHED; PG8_LDA(At, 0, 0); PG8_STAGE(PG8_SA(1, 1), a1 + hstepA, offC[1]);
            PG8_WAIT_L(8); PG8_BAR; PG8_WAIT_L(0); PG8_MMA(0, 0, At, B0); PG8_BAR; PG8_SCHED;
            PG8_LDB(B1, 0, 1); PG8_STAGE(PG8_SB(0, 0), b2, voffB);
            PG8_BAR; PG8_WAIT_L(0); PG8_MMA(0, 1, At, B1); PG8_BAR;
            PG8_LDA(At, 0, 1); PG8_STAGE(PG8_SA(0, 0), a2, o2[0]);
            PG8_BAR; PG8_WAIT_L(0); PG8_MMA(1, 0, At, B0); PG8_BAR; PG8_SCHED;
            PG8_STAGE(PG8_SB(0, 1), b2 + hstepB, voffB);
            PG8_WAIT_V(6); PG8_BAR; PG8_MMA(1, 1, At, B1); PG8_BAR;
            PG8_LDB(B0, 1, 0); PG8_SCHED; PG8_LDA(At, 1, 0); PG8_STAGE(PG8_SA(0, 1), a2 + hstepA, o2[1]);
            PG8_WAIT_L(8); PG8_BAR; PG8_WAIT_L(0); PG8_MMA(0, 0, At, B0); PG8_BAR; PG8_SCHED;
            PG8_LDB(B1, 1, 1); PG8_STAGE(PG8_SB(1, 0), b3, voffB);
            PG8_BAR; PG8_WAIT_L(0); PG8_MMA(0, 1, At, B1); PG8_BAR;
            PG8_LDA(At, 1, 1); PG8_STAGE(PG8_SA(1, 0), a3, o2[0]);
            PG8_BAR; PG8_WAIT_L(0); PG8_MMA(1, 0, At, B0); PG8_BAR; PG8_SCHED;
            PG8_STAGE(PG8_SB(1, 1), b3 + hstepB, voffB);
            PG8_WAIT_V(6); PG8_BAR; PG8_MMA(1, 1, At, B1); PG8_BAR;
            }
        }
        if constexpr (ALIGN_EPI) { if (wr == 0) PG8_BAR; }
        if constexpr (!Epi::AFTER_DRAIN) { E(acc, cur, wr, wc, fr, fq); S.done(cur); }
        if (!has_next) break;
#pragma unroll
        for (int a = 0; a < 2; ++a)
#pragma unroll
            for (int b = 0; b < 2; ++b)
#pragma unroll
                for (int m = 0; m < 4; ++m)
#pragma unroll
                    for (int n = 0; n < 2; ++n) acc[a][b][m][n] = (f32x4){0.f, 0.f, 0.f, 0.f};
        cur = nxt; cA = nA; cB = nB; ++ui;
#pragma unroll
        for (int h = 0; h < 2; ++h)
#pragma unroll
            for (int i = 0; i < 2; ++i) offC[h][i] = offN[h][i];
        if constexpr (ALIGN_EPI) { if (wr == 1) PG8_BAR; }
    }
    PG8_WAIT_V(0);
    if constexpr (!ALIGN_EPI) { if (wr == 0) PG8_BAR; }
    PG8_BAR;
    if constexpr (Epi::AFTER_DRAIN) { E.fused(acc, cur, wr, wc, fr, fq, lds, wid, lane); S.done(cur); }
#undef PG8_SA
#undef PG8_SB
#undef PG8_STAGE
#undef PG8_LDA
#undef PG8_LDB
#undef PG8_MMA
#undef PG8_WAIT_V
#undef PG8_WAIT_L
#undef PG8_BAR
#undef PG8_SCHED
}
}
#ifndef PG8_SP2
#define PG8_SP2 true
#endif
#ifndef PG8_ALIGN
#define PG8_ALIGN true
#endif
constexpr int NWAVES = 8;
constexpr int BATCH = 2, SEQ = 16384, T = BATCH * SEQ, D = 2048;
constexpr int NH = 8, HD = 128, GW = 1024, SCW = 1024;
constexpr int IN_COLS = 7184, NPROJ = 7168;
constexpr int NE = 64, DE = 512, CAP_ROWS = 65536 + 64 * 256, MAX_TILES = CAP_ROWS / 256;
constexpr float EPS = 1e-6f;
constexpr int N_PHASES = 11;
constexpr int NSCAN = 2 * BATCH * NH;
constexpr int GDN_SPLIT = 128;

constexpr size_t MiB = 1u << 20;
constexpr size_t WS_CTL = 0, CTL_ZERO_BYTES = 1 * MiB;
constexpr size_t WS_BA = 1 * MiB;
constexpr size_t WS_GB = 3 * MiB;
constexpr size_t WS_RSTD = 5 * MiB;
constexpr size_t WS_EID = 6 * MiB;
constexpr size_t WS_GATE = 7 * MiB;
constexpr size_t WS_POS = 8 * MiB;
constexpr size_t WS_ROWTOK = 9 * MiB;
constexpr size_t WS_ROWGATE = 10 * MiB;
constexpr size_t WS_TILES = 11 * MiB;
constexpr size_t WS_ROWSC = 11 * MiB + 512 * 1024;
constexpr size_t WS_DSC = 12 * MiB;
constexpr size_t WS_SBUF = 15 * MiB;
constexpr size_t WS_CNT = 13 * MiB;
constexpr size_t WS_WR = 14 * MiB;
constexpr size_t WS_SSQ = 940 * MiB;
constexpr size_t WS_WIN = 16 * MiB;
constexpr size_t WS_WOUT = 44 * MiB;
constexpr size_t WS_R0 = 52 * MiB;
constexpr size_t WS_R1 = 180 * MiB;
constexpr size_t WS_R3 = 628 * MiB;
constexpr size_t WS_H1B = 948 * MiB;
constexpr size_t WS_END = 1076 * MiB;
constexpr size_t GI_NW = 0, GI_QD = 16384, GI_AT = 32768, GI_KD = 40960, GI_DMA = 57344, GI_U = 57344, GI_UNIT = 73728;
constexpr size_t PROJ_T = (size_t)T * 1024;
constexpr size_t WGU_ELEMS = (size_t)NE * 1024 * 2048;

constexpr int RING_OFF = 0, RING_BYTES = 131072;
constexpr int LDS_BYTES = 151552;
constexpr int LDSCTL_OFF = LDS_BYTES - 256, MISC_OFF = LDSCTL_OFF;
constexpr int P2_KN = 0, P2_QN = 17408, P2_XT = 0  , P2_KT = 34816, P2_VT = 53248, P2_AM = 71680, P2_AT = 89088, P2_TU = 98304, P2_TW = 107520, P2_SM = 116736, P2_CW = 120832;
constexpr int P3_UB = 114688, P3_OB = 131072, P3_DL = 148480, P3_NW = 149504;
static_assert(P3_NW + 512 <= LDSCTL_OFF, "LDS map");

#define GAS __attribute__((address_space(1)))
#define LAS __attribute__((address_space(3)))
typedef unsigned short bf16;
typedef unsigned v4u __attribute__((ext_vector_type(4)));
typedef unsigned v2u __attribute__((ext_vector_type(2)));
typedef float f32x4 __attribute__((ext_vector_type(4)));
typedef GAS unsigned gu32;
typedef float f32x16 __attribute__((ext_vector_type(16)));
typedef short bf16x8 __attribute__((ext_vector_type(8)));
typedef __bf16 bf16x2_t __attribute__((ext_vector_type(2)));
typedef float f32x2_t __attribute__((ext_vector_type(2)));
__device__ __forceinline__ unsigned cvtpk(float lo, float hi) { f32x2_t v = {lo, hi}; bf16x2_t b = __builtin_convertvector(v, bf16x2_t); return __builtin_bit_cast(unsigned, b); }
#define pack8(X, s) __builtin_bit_cast(bf16x8, (v4u){cvtpk((X)[8 * (s)], (X)[8 * (s) + 1]), cvtpk((X)[8 * (s) + 2], (X)[8 * (s) + 3]), cvtpk((X)[8 * (s) + 4], (X)[8 * (s) + 5]), cvtpk((X)[8 * (s) + 6], (X)[8 * (s) + 7])})
#define RLX_AGENT __ATOMIC_RELAXED, __HIP_MEMORY_SCOPE_AGENT
#define LDS_WAIT() asm volatile("s_waitcnt lgkmcnt(0)" ::: "memory")
#define VM_WAIT() asm volatile("s_waitcnt vmcnt(0)" ::: "memory")
__device__ __forceinline__ unsigned f2bf(float f) { unsigned u = __builtin_bit_cast(unsigned, f); return (u + 0x7fffu + ((u >> 16) & 1u)) >> 16; }
__device__ __forceinline__ unsigned pk2(float lo, float hi) { return f2bf(lo) | (f2bf(hi) << 16); }
__device__ __forceinline__ float bflo(unsigned u) { return __builtin_bit_cast(float, u << 16); }
__device__ __forceinline__ float bfhi(unsigned u) { return __builtin_bit_cast(float, u & 0xffff0000u); }
__device__ __forceinline__ float wave_sum(float v) {
#pragma unroll
    for (int o = 1; o < 64; o <<= 1) v += __shfl_xor(v, o);
    return v;
}
__device__ __forceinline__ float siluf(float x) { return x * __builtin_amdgcn_rcpf(1.0f + __expf(-x)); }

#define XB_TMO      128
#define XB_XCNT(j)  (256  + 64 * (j))
#define XB_XSUB(j)  (1280 + 64 * (j))
#define XB_XGEN(j)  (2304 + 64 * (j))
#define XB_TOP      3328
#define XB_TOPGEN   3392
#define XCD_BAR_WORDS 3456
#define XB_SPIN_CAP (1u << 18)
__device__ __forceinline__ unsigned xb_ld(unsigned* p)              { return __hip_atomic_load(p, __ATOMIC_RELAXED, __HIP_MEMORY_SCOPE_AGENT); }
__device__ __forceinline__ unsigned xb_add(unsigned* p, unsigned v) { return __hip_atomic_fetch_add(p, v, __ATOMIC_RELAXED, __HIP_MEMORY_SCOPE_AGENT); }
__device__ __forceinline__ unsigned xb_xcc_id() { return (unsigned)__builtin_amdgcn_s_getreg((3 << 11) | 20) & 0xFu; }
#define XB_SPIN(cond, bar) do { unsigned _sp = 0; while (cond) { __builtin_amdgcn_s_sleep(1); \
    if ((++_sp & 255u) == 0u) { if (xb_ld(&(bar)[XB_TMO])) break; if (_sp > XB_SPIN_CAP) { atomicAdd(&(bar)[XB_TMO], 1u); break; } } } } while (0)
struct XcdBarrier { unsigned* bar; unsigned x; volatile LAS unsigned* st; int wv; };
#define XB_T0(wv) ((wv) == 0 && lane_id_v() == 0)
__device__ __forceinline__ XcdBarrier xcd_barrier_post(unsigned* bar, volatile LAS unsigned* st, int wv) {
    XcdBarrier b; b.bar = bar; b.x = xb_xcc_id(); b.st = st; b.wv = wv;
    if (XB_T0(wv)) (void)xb_add(&bar[XB_XCNT(b.x)], 1u);
    return b;
}
__device__ __forceinline__ void xcd_barrier_complete(unsigned* bar, unsigned x, unsigned& nloc, unsigned& nx) {
    const unsigned G = gridDim.x * gridDim.y * gridDim.z;
    unsigned sum, cnt, mine, sp = 0u;
    for (;;) {
        sum = 0u; cnt = 0u; mine = 0u;
#pragma unroll
        for (unsigned j = 0; j < 16; ++j) { const unsigned c = xb_ld(&bar[XB_XCNT(j)]); sum += c; cnt += (c > 0u) ? 1u : 0u; mine = (j == x) ? c : mine; }
        if (sum == G) break;
        __builtin_amdgcn_s_sleep(1);
        if ((++sp & 255u) == 0u) { if (xb_ld(&bar[XB_TMO])) break; if (sp > XB_SPIN_CAP) { atomicAdd(&bar[XB_TMO], 1u); break; } }
    }
    nloc = mine > 0u ? mine : 1u; nx = cnt > 0u ? cnt : 1u;
}
__device__ __forceinline__ void xcd_barrier(const XcdBarrier& b) {
    asm volatile("s_waitcnt vmcnt(0)" ::: "memory");
    __syncthreads();
    if (XB_T0(b.wv)) {
        unsigned* bar = b.bar;
        __builtin_amdgcn_s_waitcnt(0);
        unsigned nloc = b.st[0], nx = b.st[1];
        if (nloc == 0u) { xcd_barrier_complete(bar, b.x, nloc, nx); b.st[0] = nloc; b.st[1] = nx; }
        const unsigned old = xb_add(&bar[XB_XSUB(b.x)], 1u);
        const unsigned gen = old / nloc;
        if (old + 1u == (gen + 1u) * nloc) {
            __builtin_amdgcn_fence(__ATOMIC_RELEASE, "agent");
            asm volatile("s_waitcnt vmcnt(0)" ::: "memory");
            const unsigned og = xb_add(&bar[XB_TOP], 1u);
            const unsigned tg = og / nx;
            if (og + 1u == (tg + 1u) * nx) xb_add(&bar[XB_TOPGEN], 1u);
            else XB_SPIN(xb_ld(&bar[XB_TOPGEN]) == tg, bar);
            __builtin_amdgcn_fence(__ATOMIC_ACQUIRE, "agent");
            xb_add(&bar[XB_XGEN(b.x)], 1u);
            asm volatile("s_waitcnt vmcnt(0)" ::: "memory");
        } else {
            XB_SPIN(xb_ld(&bar[XB_XGEN(b.x)]) == gen, bar);
            __builtin_amdgcn_fence(__ATOMIC_ACQUIRE, "agent");
            asm volatile("s_waitcnt vmcnt(0)" ::: "memory");
        }
    }
    __syncthreads();
}

__device__ __forceinline__ void transpose_item(const float* W, int ldw, int scol0, int k0, bf16* WT, int K, int drow0, LAS float* scr, int lane, const float* kscale) {
    f32x4 v[16];
    f32x4 s0 = (f32x4){1.f, 1.f, 1.f, 1.f}, s1 = s0;
    if (kscale) { s0 = *(const f32x4*)(kscale + k0 + 8 * (lane & 7)); s1 = *(const f32x4*)(kscale + k0 + 8 * (lane & 7) + 4); }
    const float* src = W + (size_t)(k0 + (lane >> 4)) * ldw + scol0 + 4 * (lane & 15);
#pragma unroll
    for (int i = 0; i < 16; ++i) v[i] = __builtin_nontemporal_load((const f32x4*)(src + (size_t)(4 * i) * ldw));
#pragma unroll
    for (int i = 0; i < 16; ++i) { LAS float* d = scr + (4 * i + (lane >> 4)) * 65 + 4 * (lane & 15); d[0] = v[i].x; d[1] = v[i].y; d[2] = v[i].z; d[3] = v[i].w; }
    LDS_WAIT(); asm volatile("" ::: "memory");
#pragma unroll
    for (int q = 0; q < 8; ++q) { const int t = lane + 64 * q, n = t >> 3, c8 = t & 7; const LAS float* sp = scr + (8 * c8) * 65 + n;
        float e[8];
#pragma unroll
        for (int j = 0; j < 8; ++j) e[j] = sp[j * 65];
        v4u o; o.x = cvtpk(e[0] * s0.x, e[1] * s0.y); o.y = cvtpk(e[2] * s0.z, e[3] * s0.w); o.z = cvtpk(e[4] * s1.x, e[5] * s1.y); o.w = cvtpk(e[6] * s1.z, e[7] * s1.w);
        __builtin_nontemporal_store(o, (GAS v4u*)(WT + (size_t)(drow0 + n) * K + k0 + 8 * c8)); }
    LDS_WAIT(); asm volatile("" ::: "memory");
}

__device__ __forceinline__ void gdn_prep(LAS unsigned char* lds, const int wave, const int wgi, const int nwg, const int clo, const int chi,
                                         const bf16* PROJ, const float* conv_qkv_w, const float* BA, const float* a_log, const float* dt_bias, unsigned char* GI, float* DSC) {
        LAS bf16* KNt = (LAS bf16*)(lds + P2_KN); LAS bf16* QNt = (LAS bf16*)(lds + P2_QN); LAS bf16* KTt = (LAS bf16*)(lds + P2_KT); LAS bf16* VTt = (LAS bf16*)(lds + P2_VT);
        LAS float* AMt = (LAS float*)(lds + P2_AM); LAS bf16* ATt = (LAS bf16*)(lds + P2_AT); LAS float* SMt = (LAS float*)(lds + P2_SM); LAS bf16* XTt = (LAS bf16*)(lds + P2_XT);
        LAS bf16* TUt = (LAS bf16*)(lds + P2_TU); LAS bf16* TWt = (LAS bf16*)(lds + P2_TW);
        v4u raw[3][4][2];
#define P2_RAWLOAD(qi_) do { const int ch_ = chi - 1 - (qi_) / (BATCH * NH), bh_ = (qi_) % (BATCH * NH); const int l_ = lane_id_v(), t_ = wave * 64 + l_, row_ = t_ >> 3, c0_ = (t_ & 7) * 16; \
            const int tt_ = ch_ * 64 + row_; const size_t tok_ = (size_t)(bh_ / NH) * SEQ + tt_; \
            _Pragma("unroll") for (int ten = 0; ten < 3; ++ten) { const bf16* src_ = PROJ + (size_t)ten * PROJ_T + tok_ * 1024 + (bh_ % NH) * 128 + c0_; \
                _Pragma("unroll") for (int j = 0; j < 4; ++j) { \
                    if (tt_ - 3 + j >= 0) { const v4u* p_ = (const v4u*)(src_ + (ptrdiff_t)(j - 3) * 1024); raw[ten][j][0] = p_[0]; raw[ten][j][1] = p_[1]; } \
                    else { raw[ten][j][0] = (v4u){0u, 0u, 0u, 0u}; raw[ten][j][1] = (v4u){0u, 0u, 0u, 0u}; } } } } while (0)
        if (wgi < (chi - clo) * BATCH * NH) P2_RAWLOAD(wgi);
        LAS float* CWt = (LAS float*)(lds + P2_CW); int cw_h = -1;
        for (int qi = wgi; qi < (chi - clo) * BATCH * NH; qi += nwg) {
            const int un_ch = chi - 1 - qi / (BATCH * NH), un_bh = qi % (BATCH * NH);
            const int laneu = lane_id_v(), tidu = wave * 64 + laneu;
            const int b = un_bh / NH, ch = un_ch, h = un_bh % NH, t0 = b * SEQ + ch * 64;
            const int uid = (b * NH + h) * (SEQ / 64) + ch;
            unsigned char* ub = (unsigned char*)GI + (size_t)uid * GI_UNIT;
            if (h != cw_h) {
                asm volatile("s_waitcnt lgkmcnt(0)" ::: "memory"); __builtin_amdgcn_s_barrier(); asm volatile("" ::: "memory");
#pragma unroll
                for (int i = 0; i < 3; ++i) { const int idx = tidu + NWAVES * 64 * i, ten = idx >> 9, j = (idx >> 7) & 3, c = idx & 127; CWt[idx] = conv_qkv_w[(size_t)j * 3072 + ten * 1024 + h * 128 + c]; }
                asm volatile("s_waitcnt lgkmcnt(0)" ::: "memory"); __builtin_amdgcn_s_barrier(); asm volatile("" ::: "memory");
                cw_h = h; }
            {
                const int row = tidu >> 3, c0 = (tidu & 7) * 16, tt = ch * 64 + row;
                float bl = 0.f, al = 0.f;
                if (wave == 0) { bl = BA[(size_t)(t0 + laneu) * 16 + h]; al = BA[(size_t)(t0 + laneu) * 16 + 8 + h]; }
#pragma unroll
                for (int ten = 0; ten < 3; ++ten) {
                    float acc[16];
#pragma unroll
                    for (int i = 0; i < 16; ++i) acc[i] = 0.f;
#pragma unroll
                    for (int j = 0; j < 4; ++j) {
                        {
                            const v4u a = raw[ten][j][0], bb = raw[ten][j][1];
                            const LAS f32x4* wp = (const LAS f32x4*)(CWt + (ten * 4 + j) * 128 + c0); const f32x4 w0 = wp[0], w1 = wp[1], w2 = wp[2], w3 = wp[3];
                            acc[0] += bflo(a.x) * w0.x; acc[1] += bfhi(a.x) * w0.y; acc[2] += bflo(a.y) * w0.z; acc[3] += bfhi(a.y) * w0.w;
                            acc[4] += bflo(a.z) * w1.x; acc[5] += bfhi(a.z) * w1.y; acc[6] += bflo(a.w) * w1.z; acc[7] += bfhi(a.w) * w1.w;
                            acc[8] += bflo(bb.x) * w2.x; acc[9] += bfhi(bb.x) * w2.y; acc[10] += bflo(bb.y) * w2.z; acc[11] += bfhi(bb.y) * w2.w;
                            acc[12] += bflo(bb.z) * w3.x; acc[13] += bfhi(bb.z) * w3.y; acc[14] += bflo(bb.w) * w3.z; acc[15] += bfhi(bb.w) * w3.w;
                        }
                    }
                    float ss = 0.f;
#pragma unroll
                    for (int i = 0; i < 16; ++i) { acc[i] = siluf(acc[i]); ss += acc[i] * acc[i]; }
                    ss += __shfl_xor(ss, 1); ss += __shfl_xor(ss, 2); ss += __shfl_xor(ss, 4);
                    const float sc = (ten == 0) ? rsqrtf(ss + EPS) * 0.08838834764831845f : (ten == 1 ? rsqrtf(ss + EPS) : 1.f);
                    unsigned pw[8];
#pragma unroll
                    for (int i = 0; i < 8; ++i) pw[i] = cvtpk(acc[2 * i] * sc, acc[2 * i + 1] * sc);
                    if (ten < 2) { v4u o0, o1; o0.x = pw[0]; o0.y = pw[1]; o0.z = pw[2]; o0.w = pw[3]; o1.x = pw[4]; o1.y = pw[5]; o1.z = pw[6]; o1.w = pw[7];
                        LAS v4u* dst = (LAS v4u*)((ten == 0 ? QNt : KNt) + row * 136 + c0); dst[0] = o0; dst[1] = o1; }
                    if (ten >= 1) { LAS bf16* tp = (ten == 1 ? KTt : VTt) + c0 * 72 + row;
#pragma unroll
                        for (int i = 0; i < 8; ++i) { tp[(2 * i) * 72] = (bf16)pw[i]; tp[(2 * i + 1) * 72] = (bf16)(pw[i] >> 16); } }
                }
                if (wave == 0) {
                    const float xs = al + dt_bias[h]; const float sp = xs > 20.f ? xs : __logf(1.0f + __expf(xs));
                    float gcv = -__expf(a_log[h]) * sp;
#pragma unroll
                    for (int o = 1; o < 64; o <<= 1) { const float v = __shfl_up(gcv, o); if (laneu >= o) gcv += v; }
                    const float gl = __shfl(gcv, 63);
                    SMt[laneu] = gcv; SMt[64 + laneu] = __expf(gcv); SMt[128 + laneu] = __expf(gl - gcv); SMt[192 + laneu] = __builtin_amdgcn_rcpf(1.0f + __expf(-bl));
                    if (laneu == 0) DSC[uid] = __expf(gl);
                }
            }
            asm volatile("s_waitcnt lgkmcnt(0)" ::: "memory"); __builtin_amdgcn_s_barrier(); asm volatile("" ::: "memory");
            {
                const int mat = wave >> 2, mb = wave & 3, fr = laneu & 15, fg = laneu >> 4;
                const LAS bf16* Am = mat ? QNt : KNt;
                pg8::bf16x8 af[4], bfr[4][4];
#pragma unroll
                for (int ks = 0; ks < 4; ++ks) af[ks] = *(const LAS pg8::bf16x8*)(Am + (16 * mb + fr) * 136 + 32 * ks + 8 * fg);
#pragma unroll
                for (int nb = 0; nb < 4; ++nb)
#pragma unroll
                    for (int ks = 0; ks < 4; ++ks) bfr[nb][ks] = *(const LAS pg8::bf16x8*)(KNt + (16 * nb + fr) * 136 + 32 * ks + 8 * fg);
                float gi[4], bi[4], gj[4];
#pragma unroll
                for (int r = 0; r < 4; ++r) { gi[r] = SMt[16 * mb + 4 * fg + r]; bi[r] = SMt[192 + 16 * mb + 4 * fg + r]; gj[r] = SMt[16 * r + fr]; }
                pg8::f32x4 acc[4];
#pragma unroll
                for (int nb = 0; nb < 4; ++nb) acc[nb] = (pg8::f32x4){0.f, 0.f, 0.f, 0.f};
#pragma unroll
                for (int ks = 0; ks < 4; ++ks)
#pragma unroll
                    for (int nb = 0; nb < 4; ++nb) acc[nb] = __builtin_amdgcn_mfma_f32_16x16x32_bf16(af[ks], bfr[nb][ks], acc[nb], 0, 0, 0);
#pragma unroll
                for (int nb = 0; nb < 4; ++nb) {
                    const int j = 16 * nb + fr; f32x4 av; unsigned short tv[4];
#pragma unroll
                    for (int r = 0; r < 4; ++r) {
                        const int i = 16 * mb + 4 * fg + r;
                        const float dec = (i >= j) ? __expf(gi[r] - gj[nb]) : 0.f;
                        av[r] = (i > j) ? bi[r] * acc[nb][r] * dec : 0.f;
                        tv[r] = (unsigned short)f2bf(acc[nb][r] * dec);
                    }
                    if (mat == 0) *(LAS f32x4*)(AMt + j * 68 + 16 * mb + 4 * fg) = av;
                    else {
#pragma unroll
                        for (int r = 0; r < 4; ++r) ATt[(16 * mb + 4 * fg + r) * 72 + j] = (bf16)tv[r]; }
                }
            }
            asm volatile("s_waitcnt lgkmcnt(0)" ::: "memory"); __builtin_amdgcn_s_barrier(); asm volatile("" ::: "memory");
            if (wave == 0) {
                const int c = laneu; f32x4 xq[16];
#pragma unroll
                for (int i = 0; i < 64; ++i) xq[i >> 2][i & 3] = (i == c) ? 1.f : 0.f;
                const LAS float* AMb = AMt; asm volatile("" : "+v"(AMb));
#pragma unroll
                for (int bq = 0; bq < 16; ++bq) {
                    const f32x4 d0 = *(const LAS f32x4*)(AMb + (4 * bq) * 68 + 4 * bq), d1 = *(const LAS f32x4*)(AMb + (4 * bq + 1) * 68 + 4 * bq), d2 = *(const LAS f32x4*)(AMb + (4 * bq + 2) * 68 + 4 * bq);
                    const float x0 = xq[bq].x;
                    const float x1 = xq[bq].y - d0.y * x0;
                    const float x2 = (xq[bq].z - d0.z * x0) - d1.z * x1;
                    const float x3 = ((xq[bq].w - d0.w * x0) - d1.w * x1) - d2.w * x2;
                    xq[bq] = (f32x4){x0, x1, x2, x3};
#pragma unroll
                    for (int q = bq + 1; q < 16; ++q) {
                        const f32x4 r0 = *(const LAS f32x4*)(AMb + (4 * bq) * 68 + 4 * q), r1 = *(const LAS f32x4*)(AMb + (4 * bq + 1) * 68 + 4 * q), r2 = *(const LAS f32x4*)(AMb + (4 * bq + 2) * 68 + 4 * q), r3 = *(const LAS f32x4*)(AMb + (4 * bq + 3) * 68 + 4 * q);
                        xq[q] -= (r0 * x0 + r1 * x1) + (r2 * x2 + r3 * x3);
                    }
                }
                const float su = SMt[192 + c], sw = -SMt[192 + c] * SMt[64 + c];
#pragma unroll
                for (int i = 0; i < 64; i += 2) { const unsigned pu = cvtpk(xq[i >> 2][i & 3] * su, xq[(i + 1) >> 2][(i + 1) & 3] * su), pw2 = cvtpk(xq[i >> 2][i & 3] * sw, xq[(i + 1) >> 2][(i + 1) & 3] * sw);
                    TUt[i * 72 + c] = (bf16)pu; TUt[(i + 1) * 72 + c] = (bf16)(pu >> 16); TWt[i * 72 + c] = (bf16)pw2; TWt[(i + 1) * 72 + c] = (bf16)(pw2 >> 16); }
            } else if (wave < 4) {
            } else {
                const int t2 = tidu - 256;
#pragma unroll 1
                for (int q = 0; q < 4; ++q) {
                    const int p = t2 + 256 * q, blk = p >> 6, l = p & 63, r = l & 31, hh = l >> 5, mb = blk >> 3, ks = blk & 7, i = 32 * mb + r;
                    const v2u lo = *(const LAS v2u*)(QNt + i * 136 + 16 * ks + 4 * hh), hi2 = *(const LAS v2u*)(QNt + i * 136 + 16 * ks + 8 + 4 * hh); const float e = SMt[64 + i];
                    v4u o; o.x = pk2(bflo(lo.x) * e, bfhi(lo.x) * e); o.y = pk2(bflo(lo.y) * e, bfhi(lo.y) * e); o.z = pk2(bflo(hi2.x) * e, bfhi(hi2.x) * e); o.w = pk2(bflo(hi2.y) * e, bfhi(hi2.y) * e);
                    *(v4u*)(ub + GI_QD + (size_t)p * 16) = o;
                }
#pragma unroll 1
                for (int q = 0; q < 4; ++q) {
                    const int p = t2 + 256 * q, blk = p >> 6, l = p & 63, r = l & 31, hh = l >> 5, mb = blk >> 2, ks = blk & 3, d = 32 * mb + r;
                    float v[8];
#pragma unroll
                    for (int j = 0; j < 8; ++j) { const int ip = 16 * ks + 8 * (j >> 2) + 4 * hh + (j & 3); v[j] = bflo(KNt[ip * 136 + d]) * SMt[128 + ip]; }
                    v4u o; o.x = pk2(v[0], v[1]); o.y = pk2(v[2], v[3]); o.z = pk2(v[4], v[5]); o.w = pk2(v[6], v[7]);
                    *(v4u*)(ub + GI_KD + (size_t)p * 16) = o;
                }
#pragma unroll 1
                for (int q = 0; q < 2; ++q) {
                    const int p = t2 + 256 * q, blk = p >> 6, l = p & 63, r = l & 31, hh = l >> 5, mb = blk >> 2, ks = blk & 3, i = 32 * mb + r;
                    const v2u lo = *(const LAS v2u*)(ATt + i * 72 + 16 * ks + 4 * hh), hi2 = *(const LAS v2u*)(ATt + i * 72 + 16 * ks + 8 + 4 * hh);
                    v4u o; o.x = lo.x; o.y = lo.y; o.z = hi2.x; o.w = hi2.y;
                    *(v4u*)(ub + GI_AT + (size_t)p * 16) = o;
                }
            }
            asm volatile("s_waitcnt lgkmcnt(0)" ::: "memory"); __builtin_amdgcn_s_barrier(); asm volatile("" ::: "memory");
            if (qi + nwg < (chi - clo) * BATCH * NH) P2_RAWLOAD(qi + nwg);
            {
                const int mat = wave >> 2, mb = wave & 3, fr = laneu & 15, fg = laneu >> 4;
                const LAS bf16* Tm = mat ? TWt : TUt; const LAS bf16* Bm = mat ? KTt : VTt;
                const pg8::bf16x8 a0 = *(const LAS pg8::bf16x8*)(Tm + (16 * mb + fr) * 72 + 8 * fg), a1 = *(const LAS pg8::bf16x8*)(Tm + (16 * mb + fr) * 72 + 32 + 8 * fg);
                pg8::bf16x8 b0[8], b1[8];
#pragma unroll
                for (int nb = 0; nb < 8; ++nb) { b0[nb] = *(const LAS pg8::bf16x8*)(Bm + (16 * nb + fr) * 72 + 8 * fg); b1[nb] = *(const LAS pg8::bf16x8*)(Bm + (16 * nb + fr) * 72 + 32 + 8 * fg); }
                pg8::f32x4 acc[8];
#pragma unroll
                for (int nb = 0; nb < 8; ++nb) acc[nb] = __builtin_amdgcn_mfma_f32_16x16x32_bf16(a0, b0[nb], (pg8::f32x4){0.f, 0.f, 0.f, 0.f}, 0, 0, 0);
#pragma unroll
                for (int nb = 0; nb < 8; ++nb) acc[nb] = __builtin_amdgcn_mfma_f32_16x16x32_bf16(a1, b1[nb], acc[nb], 0, 0, 0);
#pragma unroll
                for (int nb = 0; nb < 8; ++nb) {
                    const unsigned p01 = cvtpk(acc[nb][0], acc[nb][1]), p23 = cvtpk(acc[nb][2], acc[nb][3]); LAS bf16* xp = XTt + (16 * mb + 4 * fg) * 264 + mat * 128 + 16 * nb + fr;
                    xp[0] = (bf16)p01; xp[264] = (bf16)(p01 >> 16); xp[528] = (bf16)p23; xp[792] = (bf16)(p23 >> 16);
                }
            }
            asm volatile("s_waitcnt lgkmcnt(0)" ::: "memory"); __builtin_amdgcn_s_barrier(); asm volatile("" ::: "memory");
            {
#pragma unroll 1
                for (int q = 0; q < 2; ++q) {
                    const int p = tidu + 512 * q, blk = p >> 6, l = p & 63, r = l & 31, hh = l >> 5, mb = blk >> 3, ks = blk & 7, i = 32 * mb + r;
                    const v2u lo = *(const LAS v2u*)(XTt + i * 264 + 128 + 16 * ks + 4 * hh), hi2 = *(const LAS v2u*)(XTt + i * 264 + 128 + 16 * ks + 8 + 4 * hh);
                    v4u o; o.x = lo.x; o.y = lo.y; o.z = hi2.x; o.w = hi2.y;
                    *(v4u*)(ub + GI_NW + (size_t)p * 16) = o;
                }
                {
                    const int p = tidu, blk = p >> 6, l = p & 63, r = l & 31, hh = l >> 5, nq = blk >> 1, mb = blk & 1, col = 32 * nq + r;
                    unsigned w[8];
#pragma unroll
                    for (int rg = 0; rg < 16; rg += 2) { const int i0 = 32 * mb + (rg & 3) + 8 * (rg >> 2) + 4 * hh; w[rg >> 1] = (unsigned)XTt[i0 * 264 + col] | ((unsigned)XTt[(i0 + 1) * 264 + col] << 16); }
                    v4u o0, o1; o0.x = w[0]; o0.y = w[1]; o0.z = w[2]; o0.w = w[3]; o1.x = w[4]; o1.y = w[5]; o1.z = w[6]; o1.w = w[7];
                    v4u* dst = (v4u*)(ub + GI_U + (size_t)p * 32); dst[0] = o0; dst[1] = o1;
                }
            }
            asm volatile("s_waitcnt lgkmcnt(0)" ::: "memory"); __builtin_amdgcn_s_barrier(); asm volatile("" ::: "memory");
        }
}

#undef P2_RAWLOAD
__device__ __forceinline__ void gdn_scan(LAS unsigned char* lds, const int wave, const int bh, const int half, const int c0, const int c1,
                                         const unsigned char* GI, const float* DSC, bf16* Y, float* SBUF) {
        {
            const int b = bh / NH, h = bh % NH; const int lane = lane_id_v(), tid = wave * 64 + lane;
            const unsigned char* gbase = (const unsigned char*)GI + (size_t)bh * (SEQ / 64) * GI_UNIT;
            LAS unsigned short* OB = (LAS unsigned short*)(lds + P3_OB);
            LAS unsigned char* UB = lds + P3_UB;
            LAS float* DL = (LAS float*)(lds + P3_DL);
            constexpr int NCH = SEQ / 64;
            if (tid < NCH) DL[tid] = DSC[bh * NCH + tid];
            if (wave == 2 || wave == 3) {
                asm volatile("s_waitcnt lgkmcnt(0)" ::: "memory"); __builtin_amdgcn_s_barrier();
                constexpr int PFD = 5; const int pw = wave - 2;
                v4u sink = (v4u){0u, 0u, 0u, 0u};
                for (int c = c0; c < c1; ++c) {
                    if (c + PFD < c1) {
                        const unsigned char* ub = gbase + (size_t)(c + PFD) * GI_UNIT + lane * 16;
#pragma unroll
                        for (int i = 0; i < 14; ++i) { const unsigned char* ad = ub + (half * 28 + pw * 14 + i) * 1024; asm volatile("global_load_dwordx4 %0, %1, off" : "+v"(sink) : "v"(ad)); }
#pragma unroll
                        for (int i = 0; i < 4; ++i) { const unsigned char* ad = ub + (int)GI_U + half * 8192 + (pw * 4 + i) * 1024; asm volatile("global_load_dwordx4 %0, %1, off" : "+v"(sink) : "v"(ad)); }
                    }
                    __builtin_amdgcn_s_barrier(); __builtin_amdgcn_s_barrier();
                }
                asm volatile("s_waitcnt vmcnt(0)" ::: "memory"); asm volatile("" :: "v"(sink));
            } else if (wave < 2) {
                __builtin_amdgcn_s_setprio(3);
                const int nq = half * 2 + wave, r = lane & 31, hh = lane >> 5;
                f32x16 S[4], O[2];
#pragma unroll
                for (int i = 0; i < 16; ++i) { S[0][i] = 0.f; S[1][i] = 0.f; S[2][i] = 0.f; S[3][i] = 0.f; O[0][i] = 0.f; O[1][i] = 0.f; }
                float* sbp = SBUF + ((size_t)(bh * 4 + nq) * 64 + lane) * 64;
                if (c0 > 0) {
#pragma unroll
                    for (int t = 0; t < 4; ++t)
#pragma unroll
                        for (int q = 0; q < 4; ++q) { const f32x4 v = *(const f32x4*)(sbp + t * 16 + q * 4); S[t][4 * q] = v.x; S[t][4 * q + 1] = v.y; S[t][4 * q + 2] = v.z; S[t][4 * q + 3] = v.w; }
                }
#define P3_FOFF(i) ((i) < 32 ? ((((i) & 3) < 2 ? (int)GI_NW : (int)GI_QD) + ((((i) & 1) * 8 + ((i) >> 2)) * 64) * 16) \
                             : ((((i) - 32) % 6) < 2 ? (int)GI_AT + (((((i) - 32) % 6) * 4 + ((i) - 32) / 6) * 64) * 16 : (int)GI_KD + ((((((i) - 32) % 6) - 2) * 4 + ((i) - 32) / 6) * 64) * 16))
                constexpr int PD = 6;
                asm volatile("s_waitcnt lgkmcnt(0)" ::: "memory"); __builtin_amdgcn_s_barrier(); asm volatile("" ::: "memory");
                for (int c = c0; c < c1; ++c) {
                    const LAS unsigned char* ab = lds + (c & 1) * GI_DMA + lane * 16;
                    bf16x8 R[PD];
#pragma unroll
                    for (int i = 0; i < PD; ++i) R[i] = *(const LAS bf16x8*)(ab + P3_FOFF(i));
                    const float dcur = DL[c];
                    f32x16 V[2];
                    { const v4u ua = *(const LAS v4u*)(UB + ((nq * 2) * 64 + lane) * 32), ub2 = *(const LAS v4u*)(UB + ((nq * 2) * 64 + lane) * 32 + 16);
                      const v4u uc = *(const LAS v4u*)(UB + ((nq * 2 + 1) * 64 + lane) * 32), ud = *(const LAS v4u*)(UB + ((nq * 2 + 1) * 64 + lane) * 32 + 16);
                      V[0][0] = bflo(ua.x); V[0][1] = bfhi(ua.x); V[0][2] = bflo(ua.y); V[0][3] = bfhi(ua.y); V[0][4] = bflo(ua.z); V[0][5] = bfhi(ua.z); V[0][6] = bflo(ua.w); V[0][7] = bfhi(ua.w);
                      V[0][8] = bflo(ub2.x); V[0][9] = bfhi(ub2.x); V[0][10] = bflo(ub2.y); V[0][11] = bfhi(ub2.y); V[0][12] = bflo(ub2.z); V[0][13] = bfhi(ub2.z); V[0][14] = bflo(ub2.w); V[0][15] = bfhi(ub2.w);
                      V[1][0] = bflo(uc.x); V[1][1] = bfhi(uc.x); V[1][2] = bflo(uc.y); V[1][3] = bfhi(uc.y); V[1][4] = bflo(uc.z); V[1][5] = bfhi(uc.z); V[1][6] = bflo(uc.w); V[1][7] = bfhi(uc.w);
                      V[1][8] = bflo(ud.x); V[1][9] = bfhi(ud.x); V[1][10] = bflo(ud.y); V[1][11] = bfhi(ud.y); V[1][12] = bflo(ud.z); V[1][13] = bfhi(ud.z); V[1][14] = bflo(ud.w); V[1][15] = bfhi(ud.w); }
                    bf16x8 Sb[8], Vb[4];
                    Sb[0] = pack8(S[0], 0); Sb[1] = pack8(S[0], 1); Sb[2] = pack8(S[1], 0); Sb[3] = pack8(S[1], 1); Sb[4] = pack8(S[2], 0); Sb[5] = pack8(S[2], 1); Sb[6] = pack8(S[3], 0); Sb[7] = pack8(S[3], 1);
#pragma unroll
                    for (int i = 0; i < 16; ++i) { O[0][i] = 0.f; O[1][i] = 0.f; }
                    __builtin_amdgcn_sched_barrier(0);
#define P3_STEP(i) { const bf16x8 f_ = R[(i) % PD]; \
                        if ((i) < 32) { if (((i) & 3) < 2) V[(i) & 1] = __builtin_amdgcn_mfma_f32_32x32x16_bf16(f_, Sb[((i) >> 2) & 7], V[(i) & 1], 0, 0, 0); else O[(i) & 1] = __builtin_amdgcn_mfma_f32_32x32x16_bf16(f_, Sb[((i) >> 2) & 7], O[(i) & 1], 0, 0, 0); } \
                        else { if ((((i) - 32) % 6) < 2) O[(((i) - 32) % 6) & 1] = __builtin_amdgcn_mfma_f32_32x32x16_bf16(f_, Vb[(((i) - 32) / 6) & 3], O[(((i) - 32) % 6) & 1], 0, 0, 0); \
                               else S[((((i) - 32) % 6) - 2) & 3] = __builtin_amdgcn_mfma_f32_32x32x16_bf16(f_, Vb[(((i) - 32) / 6) & 3], S[((((i) - 32) % 6) - 2) & 3], 0, 0, 0); } \
                        if ((i) + PD < 56) R[(i) % PD] = *(const LAS bf16x8*)(ab + P3_FOFF(((i) + PD) % 56)); \
                        __builtin_amdgcn_sched_barrier(0); }
#define P3_STEP8(b) P3_STEP((b)) P3_STEP((b) + 1) P3_STEP((b) + 2) P3_STEP((b) + 3) P3_STEP((b) + 4) P3_STEP((b) + 5) P3_STEP((b) + 6) P3_STEP((b) + 7)
                    P3_STEP8(0) P3_STEP8(8) P3_STEP8(16) P3_STEP8(24)
                    Vb[0] = pack8(V[0], 0); Vb[1] = pack8(V[0], 1); Vb[2] = pack8(V[1], 0); Vb[3] = pack8(V[1], 1);
#pragma unroll
                    for (int q = 0; q < 16; ++q) { S[0][q] *= dcur; S[1][q] *= dcur; S[2][q] *= dcur; S[3][q] *= dcur; }
                    __builtin_amdgcn_sched_barrier(0);
                    P3_STEP8(32) P3_STEP8(40) P3_STEP8(48)
#undef P3_STEP8
#undef P3_STEP
                    asm volatile("s_waitcnt lgkmcnt(0)" ::: "memory"); __builtin_amdgcn_s_barrier(); asm volatile("" ::: "memory");
#pragma unroll
                    for (int rg = 0; rg < 16; ++rg) { const int row = (rg & 3) + 8 * (rg >> 2) + 4 * hh; const unsigned pk_ = cvtpk(O[0][rg], O[1][rg]); OB[row * 136 + 32 * nq + r] = (unsigned short)pk_; OB[(32 + row) * 136 + 32 * nq + r] = (unsigned short)(pk_ >> 16); }
                    asm volatile("s_waitcnt lgkmcnt(0)" ::: "memory"); __builtin_amdgcn_s_barrier(); asm volatile("" ::: "memory");
                }
#undef P3_FOFF
                if (c1 < NCH) {
#pragma unroll
                    for (int t = 0; t < 4; ++t)
#pragma unroll
                        for (int q = 0; q < 4; ++q) *(f32x4*)(sbp + t * 16 + q * 4) = (f32x4){S[t][4 * q], S[t][4 * q + 1], S[t][4 * q + 2], S[t][4 * q + 3]};
                }
                __builtin_amdgcn_s_setprio(0);
            } else {
                const int lw = wave - 4, lt = tid - 256;
                const __amdgpu_buffer_rsrc_t grsrc = __builtin_amdgcn_make_buffer_rsrc((void*)gbase, 0, (int)((SEQ / 64) * GI_UNIT), 0x00020000);
                v4u ra[14], ru_a[2], rb[14], ru_b[2];
#define P3_LOAD(rs, ru, ch) do { const int so_ = (ch) * (int)GI_UNIT; \
        _Pragma("unroll") for (int k_ = 0; k_ < 14; ++k_) rs[k_] = __builtin_amdgcn_raw_buffer_load_b128(grsrc, lt * 16, so_ + k_ * 4096, 0); \
        _Pragma("unroll") for (int k_ = 0; k_ < 2; ++k_) ru[k_] = __builtin_amdgcn_raw_buffer_load_b128(grsrc, lt * 16, so_ + (int)GI_U + half * 8192 + k_ * 4096, 0); } while (0)
#define P3_PUT(rs, bufi) do { LAS unsigned char* db_ = lds + (bufi) * GI_DMA; _Pragma("unroll") for (int k_ = 0; k_ < 14; ++k_) *(LAS v4u*)(db_ + (k_ * 256 + lt) * 16) = rs[k_]; } while (0)
#define P3_PUTU(ru) do { _Pragma("unroll") for (int k_ = 0; k_ < 2; ++k_) *(LAS v4u*)(UB + half * 8192 + (k_ * 256 + lt) * 16) = ru[k_]; } while (0)
#define P3_OCOPY(cprev) do { const int tb_ = b * SEQ + (cprev) * 64, row_ = lw * 16 + (lane >> 2), sg_ = lane & 3; \
        _Pragma("unroll") for (int q_ = 0; q_ < 2; ++q_) { const v4u ov_ = *(const LAS v4u*)(OB + row_ * 136 + half * 64 + sg_ * 16 + q_ * 8); \
            *(v4u*)(Y + (size_t)(tb_ + row_) * D + h * 128 + half * 64 + sg_ * 16 + q_ * 8) = ov_; } } while (0)
#define P3_BAR() do { asm volatile("s_waitcnt lgkmcnt(0)" ::: "memory"); __builtin_amdgcn_s_barrier(); asm volatile("" ::: "memory"); } while (0)
                P3_LOAD(ra, ru_a, c0); P3_LOAD(rb, ru_b, c0 + 1);
                P3_PUT(ra, 0); P3_PUTU(ru_a);
                P3_LOAD(ra, ru_a, c0 + 2);
                P3_BAR();
                for (int c = c0; c < c1; c += 2) {
                    if (c + 1 < c1) P3_PUT(rb, 1);
                    if (c > c0) { P3_OCOPY(c - 1); }
                    P3_BAR();
                    if (c + 1 < c1) P3_PUTU(ru_b);
                    if (c + 3 < c1) P3_LOAD(rb, ru_b, c + 3);
                    P3_BAR();
                    if (c + 2 < c1) P3_PUT(ra, 0);
                    P3_OCOPY(c);
                    P3_BAR();
                    if (c + 2 < c1) P3_PUTU(ru_a);
                    if (c + 4 < c1) P3_LOAD(ra, ru_a, c + 4);
                    P3_BAR();
                }
                P3_OCOPY(c1 - 1);
#undef P3_LOAD
#undef P3_PUT
#undef P3_PUTU
#undef P3_OCOPY
#undef P3_BAR
            }
        }
}

struct Args { const float* in[18]; float* out; unsigned char* ws; int ph_lo, ph_hi; };

template <unsigned PMASK> __global__ void __launch_bounds__(NWAVES * 64, 2) fwd(Args args) {
    extern __shared__ __attribute__((aligned(16))) unsigned char lds_raw[];
    LAS unsigned char* lds = (LAS unsigned char*)lds_raw;
    const int wave = __builtin_amdgcn_readfirstlane((int)threadIdx.x >> 6);
#define PHASE_IDS const int lane = lane_id_v(), tid = wave * 64 + lane; (void)tid; (void)lane
    const int G = gridDim.x, gw = blockIdx.x * NWAVES + wave, NGW = G * NWAVES;
    unsigned char* ws = args.ws;
    const float* x = args.in[0]; const float* norm1_w = args.in[1]; const float* w_in = args.in[2]; const float* conv_qkv_w = args.in[3];
    const float* a_log = args.in[4]; const float* dt_bias = args.in[5]; const float* gdn_norm_w = args.in[6]; const float* conv_sc_w = args.in[7];
    const float* w_out = args.in[8]; const float* norm2_w = args.in[9]; const float* rgw = args.in[10]; const float* rgb = args.in[11];
    const float* rew = args.in[12]; const float* reb = args.in[13]; const float* w_gate = args.in[14]; const float* w_up = args.in[15];
    const float* w_down = args.in[16]; const float* final_w = args.in[17];
    float* out = args.out;
    float* BA = (float*)(ws + WS_BA); float* GB = (float*)(ws + WS_GB); float* RSTD = (float*)(ws + WS_RSTD);
    int* EID = (int*)(ws + WS_EID); float* GATE = (float*)(ws + WS_GATE); int* POS = (int*)(ws + WS_POS);
    float* ROWSC = (float*)(ws + WS_ROWSC); int* ROWTOK = (int*)(ws + WS_ROWTOK); float* ROWGATE = (float*)(ws + WS_ROWGATE); int* TILES = (int*)(ws + WS_TILES);
    bf16* WIN = (bf16*)(ws + WS_WIN); bf16* WOUT = (bf16*)(ws + WS_WOUT);
    bf16* HN = (bf16*)(ws + WS_R0); bf16* Y = (bf16*)(ws + WS_R0); bf16* HID = (bf16*)(ws + WS_R0);
    bf16* PROJ = (bf16*)(ws + WS_R1); bf16* WGU = (bf16*)(ws + WS_R1); bf16* WDN = (bf16*)(ws + WS_R1 + 320 * MiB);
    float* SBUF = (float*)(ws + WS_SBUF); unsigned char* GI = ws + WS_R3; int* CNT = (int*)(ws + WS_CTL + 65536);     bf16* WR = (bf16*)(ws + WS_WR); float* SSQ = (float*)(ws + WS_SSQ); bf16* H1B = (bf16*)(ws + WS_H1B); float* DSC = (float*)(ws + WS_DSC); bf16* XG = (bf16*)(ws + WS_R3); bf16* YMOE = (bf16*)(ws + WS_R3);
    const int lo = args.ph_lo, hi = args.ph_hi;
    { PHASE_IDS; for (int u = tid; u < (LDS_BYTES - LDSCTL_OFF) / 4; u += NWAVES * 64) ((LAS unsigned*)(lds + LDSCTL_OFF))[u] = 0u; }
    __syncthreads();
    XcdBarrier bar; bar.bar = (unsigned*)(ws + WS_CTL) + 4096; bar.x = 0; bar.st = nullptr; bar.wv = wave;
    if (hi - lo > 1) bar = xcd_barrier_post((unsigned*)(ws + WS_CTL) + 4096, (volatile LAS unsigned*)(lds + MISC_OFF) + 8, wave);
    const unsigned bar_x = __builtin_amdgcn_readfirstlane(bar.x);
#define SEAM(k) do { if (IN(k) && IN((k) + 1)) { unsigned* bp_ = (unsigned*)(ws + WS_CTL) + 4096; asm volatile("" : "+s"(bp_)); XcdBarrier b_; b_.bar = bp_; b_.x = bar_x; b_.st = (volatile LAS unsigned*)(lds + MISC_OFF) + 8; b_.wv = wave; xcd_barrier(b_); } } while (0)
#ifndef PROBE_MASK
#define PROBE_MASK 0u
#endif
#define SEAM_ALWAYS do { unsigned* bp_ = (unsigned*)(ws + WS_CTL) + 4096; asm volatile("" : "+s"(bp_)); XcdBarrier b_; b_.bar = bp_; b_.x = bar_x; b_.st = (volatile LAS unsigned*)(lds + MISC_OFF) + 8; b_.wv = wave; xcd_barrier(b_); } while (0)
#define PH_BEGIN(k) _Pragma("unroll") for (int rep_ = 0; rep_ < (((PROBE_MASK >> (k)) & 1u) ? 2 : 1); ++rep_) if (IN(k)) { if (rep_ > 0) SEAM_ALWAYS;
#define IN(k) (((PMASK >> (k)) & 1u) && lo <= (k) && (k) < hi)

    PH_BEGIN(0)
        PHASE_IDS;
        LAS float* scr = (LAS float*)(lds + wave * 16640);
        constexpr int I_IN = (D / 64) * (NPROJ / 64), I_OUT = (D / 64) * (D / 64);
        for (int it = gw; it < I_IN + I_OUT; it += NGW) {
            if (it < I_IN) { const int kb = it / (NPROJ / 64), nb = it % (NPROJ / 64), n0 = nb * 64; transpose_item(w_in, IN_COLS, n0 < 4096 ? n0 : n0 + 16, kb * 64, WIN, D, n0, scr, lane, nullptr); }
            else { const int r = it - I_IN, kb = r / (D / 64), nb = r % (D / 64); transpose_item(w_out, D, nb * 64, kb * 64, WOUT, D, nb * 64, scr, lane, nullptr); }
        }
        for (int item = wave * G + (int)blockIdx.x; item < 320; item += NGW) {
            if (item < 256) { const int k0 = item * 8; float v[8];
#pragma unroll
                for (int j = 0; j < 8; ++j) v[j] = rew[(size_t)(k0 + j) * 64 + lane] * norm2_w[k0 + j];
                v4u o; o.x = pk2(v[0], v[1]); o.y = pk2(v[2], v[3]); o.z = pk2(v[4], v[5]); o.w = pk2(v[6], v[7]);
                *(v4u*)(WR + (size_t)(8 + lane) * D + k0) = o; }
            else if (item < 288) { const int p = (item - 256) * 64 + lane, gq = p & 7, k0 = (p >> 3) * 8; float v[8];
#pragma unroll
                for (int j = 0; j < 8; ++j) v[j] = rgw[(size_t)(k0 + j) * 8 + gq] * norm2_w[k0 + j];
                v4u o; o.x = pk2(v[0], v[1]); o.y = pk2(v[2], v[3]); o.z = pk2(v[4], v[5]); o.w = pk2(v[6], v[7]);
                *(v4u*)(WR + (size_t)gq * D + k0) = o; }
            else { const int p = (item - 288) * 64 + lane; *(v4u*)(WR + (size_t)(72 + (p >> 8)) * D + (p & 255) * 8) = (v4u){0u, 0u, 0u, 0u}; }
        }
        __syncthreads();
        LAS bf16* wbl = (LAS bf16*)lds;
        for (int idx = tid; idx < 16 * D; idx += NWAVES * 64) { const int k = idx >> 4, c = idx & 15; wbl[c * 2056 + k] = (bf16)f2bf(w_in[(size_t)k * IN_COLS + 4096 + c]); }
        __syncthreads();
        for (int blk = gw; blk < T / 16; blk += NGW) {
#define P0_RW(r_) ((r_) * (T / 16) + blk)
            f32x4 nxa[8], nxb[8];
#define P0_LD(dst, rowi) do { const f32x4* xr_ = (const f32x4*)(x + (size_t)(rowi) * D) + lane; _Pragma("unroll") for (int j = 0; j < 8; ++j) dst[j] = xr_[64 * j]; } while (0)
#define P0_ROW(src, m_) do { f32x4 v[8]; float ss = 0.f; \
                _Pragma("unroll") for (int j = 0; j < 8; ++j) { v[j] = src[j]; ss += (v[j].x * v[j].x + v[j].y * v[j].y) + (v[j].z * v[j].z + v[j].w * v[j].w); } \
                const float rstd = rsqrtf(wave_sum(ss) * (1.f / D) + EPS); v2u* o8 = (v2u*)(HN + (size_t)(m_) * D) + lane; \
                _Pragma("unroll") for (int j = 0; j < 8; ++j) { v[j] = v[j] * rstd * wn1[j]; v2u o; o.x = cvtpk(v[j].x, v[j].y); o.y = cvtpk(v[j].z, v[j].w); o8[64 * j] = o; } } while (0)
            f32x4 wn1[8];
#pragma unroll
            for (int j = 0; j < 8; ++j) wn1[j] = *((const f32x4*)norm1_w + lane + 64 * j);
            P0_LD(nxa, P0_RW(0)); P0_LD(nxb, P0_RW(1));
#pragma unroll 1
            for (int r = 0; r < 16; r += 2) {
                { f32x4 cur[8];
#pragma unroll
                  for (int j = 0; j < 8; ++j) cur[j] = nxa[j];
                  if (r + 2 < 16) P0_LD(nxa, P0_RW(r + 2));
                  P0_ROW(cur, P0_RW(r)); }
                { f32x4 cur[8];
#pragma unroll
                  for (int j = 0; j < 8; ++j) cur[j] = nxb[j];
                  if (r + 3 < 16) P0_LD(nxb, P0_RW(r + 3));
                  P0_ROW(cur, P0_RW(r + 1)); }
            }
#undef P0_LD
#undef P0_ROW
            asm volatile("s_waitcnt vmcnt(0)" ::: "memory");
            { const int fr = lane & 15, fg = lane >> 4;
              pg8::f32x4 acc = (pg8::f32x4){0.f, 0.f, 0.f, 0.f};
              const bf16* ap = HN + (size_t)P0_RW(fr) * D + 8 * fg; const LAS bf16* bp = wbl + fr * 2056 + 8 * fg;
#pragma unroll 1
              for (int k0 = 0; k0 < D; k0 += 256) {
                  pg8::bf16x8 a[8];
#pragma unroll
                  for (int u = 0; u < 8; ++u) a[u] = *(const pg8::bf16x8*)(ap + k0 + 32 * u);
#pragma unroll
                  for (int u = 0; u < 8; ++u) { const pg8::bf16x8 bq = *(const LAS pg8::bf16x8*)(bp + k0 + 32 * u); acc = __builtin_amdgcn_mfma_f32_16x16x32_bf16(a[u], bq, acc, 0, 0, 0); }
              }
#pragma unroll
              for (int r = 0; r < 4; ++r) BA[(size_t)P0_RW(4 * fg + r) * 16 + fr] = acc[r]; }
#undef P0_RW
        }
    }

    SEAM(0);
    PH_BEGIN(1)
        PHASE_IDS;
        pg8::Gemm g{HN, WIN, T, NPROJ, D}; pg8::StaticOrder S; S.init(T, NPROJ, G, (int)blockIdx.x);
        pg8::EpiBf16S E{PROJ, 1024, 1024, PROJ_T};
        pg8::gemm_phase<pg8::EpiBf16S, pg8::StaticOrder, PG8_ALIGN, PG8_SP2>(lds + RING_OFF, g, S, E, wave);
    }

    SEAM(1);
    PH_BEGIN(2)
        PHASE_IDS;
        const bf16* PB = PROJ + 4 * PROJ_T; const bf16* PC = PROJ + 5 * PROJ_T; const bf16* PH = PROJ + 6 * PROJ_T;
        f32x4 scw[3][4];
#pragma unroll
        for (int j = 0; j < 3; ++j) { const f32x4* wp = (const f32x4*)(conv_sc_w + (size_t)j * 1024 + 16 * lane); scw[j][0] = wp[0]; scw[j][1] = wp[1]; scw[j][2] = wp[2]; scw[j][3] = wp[3]; }
        for (int t = gw; t < T; t += NGW) {
            const int tt = t % SEQ, c0 = 16 * lane;
            float acc[16];
#pragma unroll
            for (int i = 0; i < 16; ++i) acc[i] = 0.f;
#pragma unroll
            for (int j = 0; j < 3; ++j) {
                if (tt - 2 + j >= 0) {
                    const v4u* pc = (const v4u*)(PC + (size_t)(t - 2 + j) * 1024 + c0); const v4u* ph = (const v4u*)(PH + (size_t)(t - 2 + j) * 1024 + c0);
                    const v4u a = pc[0], b = pc[1], e = ph[0], f = ph[1];
                    const f32x4 w0 = scw[j][0], w1 = scw[j][1], w2 = scw[j][2], w3 = scw[j][3];
                    acc[0] += bflo(a.x) * bflo(e.x) * w0.x; acc[1] += bfhi(a.x) * bfhi(e.x) * w0.y; acc[2] += bflo(a.y) * bflo(e.y) * w0.z; acc[3] += bfhi(a.y) * bfhi(e.y) * w0.w;
                    acc[4] += bflo(a.z) * bflo(e.z) * w1.x; acc[5] += bfhi(a.z) * bfhi(e.z) * w1.y; acc[6] += bflo(a.w) * bflo(e.w) * w1.z; acc[7] += bfhi(a.w) * bfhi(e.w) * w1.w;
                    acc[8] += bflo(b.x) * bflo(f.x) * w2.x; acc[9] += bfhi(b.x) * bfhi(f.x) * w2.y; acc[10] += bflo(b.y) * bflo(f.y) * w2.z; acc[11] += bfhi(b.y) * bfhi(f.y) * w2.w;
                    acc[12] += bflo(b.z) * bflo(f.z) * w3.x; acc[13] += bfhi(b.z) * bfhi(f.z) * w3.y; acc[14] += bflo(b.w) * bflo(f.w) * w3.z; acc[15] += bfhi(b.w) * bfhi(f.w) * w3.w;
                }
            }
            const v4u* pb = (const v4u*)(PB + (size_t)t * 1024 + c0); const v4u a = pb[0], b = pb[1];
            v4u o0, o1;
            o0.x = pk2(acc[0] * bflo(a.x), acc[1] * bfhi(a.x)); o0.y = pk2(acc[2] * bflo(a.y), acc[3] * bfhi(a.y)); o0.z = pk2(acc[4] * bflo(a.z), acc[5] * bfhi(a.z)); o0.w = pk2(acc[6] * bflo(a.w), acc[7] * bfhi(a.w));
            o1.x = pk2(acc[8] * bflo(b.x), acc[9] * bfhi(b.x)); o1.y = pk2(acc[10] * bflo(b.y), acc[11] * bfhi(b.y)); o1.z = pk2(acc[12] * bflo(b.z), acc[13] * bfhi(b.z)); o1.w = pk2(acc[14] * bflo(b.w), acc[15] * bfhi(b.w));
            v4u* dst = (v4u*)(Y + (size_t)t * D + 1024 + c0); dst[0] = o0; dst[1] = o1;
        }
        gdn_prep(lds, wave, (int)blockIdx.x, G, 0, GDN_SPLIT, PROJ, conv_qkv_w, BA, a_log, dt_bias, GI, DSC);
    }

    SEAM(2);
    PH_BEGIN(3)
#define P3_ITEM(isA_, it_) do { const int it = (it_); \
                if ((isA_) && it < 16384) { const int e = it >> 8, r = it & 255, kb = r >> 5, nb = r & 31; \
                    transpose_item(w_down + (size_t)e * DE * D, D, nb * 64, kb * 64, WDN, DE, e * 2048 + nb * 64, scr, lane, nullptr); } \
                else { const int q = (isA_) ? it - 16384 : it; const int e = ((isA_) ? 48 : 0) + (q >> 9); int r = q & 511; const int up = r >> 8; r &= 255; const int kb = r >> 3, nb = r & 7, n0 = nb * 64; \
                    transpose_item((up ? w_up : w_gate) + (size_t)e * D * DE, DE, n0, kb * 64, WGU, D, (e * 4 + (e >= 48 ? 64 : 0) + (n0 >> 7)) * 256 + up * 128 + (n0 & 127), scr, lane, norm2_w); } } while (0)
#define P3_CONVERT(part) do { const int lane = lane_id_v(); LAS float* scr = (LAS float*)(lds + wave * 16640); \
            const int nh = G - NSCAN, hidx = (int)blockIdx.x - NSCAN, cw = hidx * NWAVES + wave, ncw = nh * NWAVES; \
            const int NJ = (part) == 0 ? 20992 : 28160, EXTRA = (part) == 0 ? 2 : 4; \
            const int heavy = (part) == 0 ? (((SEQ / 64 - GDN_SPLIT) * BATCH * NH) % nh) : (((T / 256) * (D / 256)) % nh);     \
            const int nlw = (nh - heavy) * NWAVES; int R = heavy ? (NJ - EXTRA * nlw) / ncw : (NJ + ncw - 1) / ncw; if (R < 0) R = 0; \
            for (int k = 0; k < R; ++k) { const int J = cw + k * ncw; if (J < NJ) { if ((part) == 0) P3_ITEM(1, J); else if (J < 24576) P3_ITEM(0, J); else P3_ITEM(1, 20992 + (J - 24576)); } } \
            if (heavy && hidx >= heavy) for (int J = R * ncw + (hidx - heavy) * NWAVES + wave; J < NJ; J += nlw) { if ((part) == 0) P3_ITEM(1, J); else if (J < 24576) P3_ITEM(0, J); else P3_ITEM(1, 20992 + (J - 24576)); } } while (0)
        if (blockIdx.x < NSCAN) gdn_scan(lds, wave, (int)blockIdx.x & 15, (int)blockIdx.x >> 4, 0, GDN_SPLIT, GI, DSC, Y, SBUF);
        else {
            const bool copy_first = ((int)blockIdx.x & 1) != 0;
#pragma unroll 1
            for (int ph = 0; ph < 2; ++ph) {
                if ((ph == 0) != copy_first) gdn_prep(lds, wave, (int)blockIdx.x - NSCAN, G - NSCAN, GDN_SPLIT, SEQ / 64, PROJ, conv_qkv_w, BA, a_log, dt_bias, GI, DSC);
                else P3_CONVERT(0);
                __syncthreads();
            } }
        SEAM_ALWAYS;
        if (blockIdx.x < NSCAN) {
            gdn_scan(lds, wave, (int)blockIdx.x & 15, (int)blockIdx.x >> 4, GDN_SPLIT, SEQ / 64, GI, DSC, Y, SBUF);
        } else {
            const bool copy_first = ((int)blockIdx.x & 1) != 0;
#pragma unroll 1
            for (int ph = 0; ph < 2; ++ph) {
                if ((ph == 0) == copy_first) P3_CONVERT(1);
                else {
                    pg8::Gemm g{Y + 1024, WOUT + 1024, T, D, 1024, D}; pg8::StaticOrder S; S.init(T, D, G - NSCAN, (int)blockIdx.x - NSCAN);
                    pg8::EpiResB16 E{x, (bf16*)out, D};
                    pg8::gemm_phase<pg8::EpiResB16, pg8::StaticOrder, PG8_ALIGN, PG8_SP2>(lds + RING_OFF, g, S, E, wave); }
                __syncthreads();
            }
        }
    }

#undef P3_CONVERT
#undef P3_ITEM
    SEAM(3);
    PH_BEGIN(4)
        PHASE_IDS;
        {
            const bf16* Zt = PROJ + 3 * PROJ_T;
            const f32x4* nwp = (const f32x4*)(gdn_norm_w + 16 * (lane & 7)); const f32x4 n0 = nwp[0], n1 = nwp[1], n2 = nwp[2], n3 = nwp[3];
            v4u noa = (v4u){0u, 0u, 0u, 0u}, nob = noa, nza = noa, nzb = noa, n2oa = noa, n2ob = noa, n2za = noa, n2zb = noa;
            if (gw < T) { const v4u* yp0 = (const v4u*)(Y + (size_t)gw * D + 16 * lane); const v4u* zp0 = (const v4u*)(Zt + (size_t)gw * 1024 + 16 * lane); noa = yp0[0]; nob = yp0[1]; nza = zp0[0]; nzb = zp0[1]; }
            if (gw + NGW < T) { const v4u* yp0 = (const v4u*)(Y + (size_t)(gw + NGW) * D + 16 * lane); const v4u* zp0 = (const v4u*)(Zt + (size_t)(gw + NGW) * 1024 + 16 * lane); n2oa = yp0[0]; n2ob = yp0[1]; n2za = zp0[0]; n2zb = zp0[1]; }
            for (int t = gw; t < T; t += NGW) {
                v4u* yp = (v4u*)(Y + (size_t)t * D + 16 * lane);
                const v4u oa = noa, ob = nob, za = nza, zb = nzb;
                noa = n2oa; nob = n2ob; nza = n2za; nzb = n2zb;
                if (t + 2 * NGW < T) { const v4u* yp1 = (const v4u*)(Y + (size_t)(t + 2 * NGW) * D + 16 * lane); const v4u* zp1 = (const v4u*)(Zt + (size_t)(t + 2 * NGW) * 1024 + 16 * lane); n2oa = yp1[0]; n2ob = yp1[1]; n2za = zp1[0]; n2zb = zp1[1]; }
                float o[16] = {bflo(oa.x), bfhi(oa.x), bflo(oa.y), bfhi(oa.y), bflo(oa.z), bfhi(oa.z), bflo(oa.w), bfhi(oa.w), bflo(ob.x), bfhi(ob.x), bflo(ob.y), bfhi(ob.y), bflo(ob.z), bfhi(ob.z), bflo(ob.w), bfhi(ob.w)};
                const float z[16] = {bflo(za.x), bfhi(za.x), bflo(za.y), bfhi(za.y), bflo(za.z), bfhi(za.z), bflo(za.w), bfhi(za.w), bflo(zb.x), bfhi(zb.x), bflo(zb.y), bfhi(zb.y), bflo(zb.z), bfhi(zb.z), bflo(zb.w), bfhi(zb.w)};
                const float nwv[16] = {n0.x, n0.y, n0.z, n0.w, n1.x, n1.y, n1.z, n1.w, n2.x, n2.y, n2.z, n2.w, n3.x, n3.y, n3.z, n3.w};
                float ss = 0.f;
#pragma unroll
                for (int i = 0; i < 16; ++i) ss += o[i] * o[i];
                ss += __shfl_xor(ss, 1); ss += __shfl_xor(ss, 2); ss += __shfl_xor(ss, 4);
                const float rs = rsqrtf(ss * (1.f / 128.f) + EPS);
#pragma unroll
                for (int i = 0; i < 16; ++i) o[i] = o[i] * rs * nwv[i] * siluf(z[i]);
                v4u ya, yb; ya.x = cvtpk(o[0], o[1]); ya.y = cvtpk(o[2], o[3]); ya.z = cvtpk(o[4], o[5]); ya.w = cvtpk(o[6], o[7]); yb.x = cvtpk(o[8], o[9]); yb.y = cvtpk(o[10], o[11]); yb.z = cvtpk(o[12], o[13]); yb.w = cvtpk(o[14], o[15]);
                yp[0] = ya; yp[1] = yb;
            }
        }
        SEAM_ALWAYS;
        pg8::Gemm g{Y, WOUT, T, D, 1024, D}; pg8::StaticOrder S; S.init(T, D, G, (int)blockIdx.x);
        pg8::EpiRes2 E{(const bf16*)out, H1B, SSQ, D};
        pg8::gemm_phase<pg8::EpiRes2, pg8::StaticOrder, PG8_ALIGN, PG8_SP2>(lds + RING_OFF, g, S, E, wave);
    }

    SEAM(4);
    PH_BEGIN(5)
        PHASE_IDS;
        constexpr int BP = 264;
        LAS bf16* Bs0 = (LAS bf16*)lds; LAS bf16* Bs1 = (LAS bf16*)(lds + 43008);
        for (int wt = blockIdx.x; wt < T / 128; wt += G) {
            const int row0 = wt * 128 + wave * 16, fr = lane & 15, fg = lane >> 4;
            pg8::f32x4 acc[5];
#pragma unroll
            for (int n = 0; n < 5; ++n) acc[n] = (pg8::f32x4){0.f, 0.f, 0.f, 0.f};
            const bf16* ap = H1B + (size_t)(row0 + fr) * D + 8 * fg;
            v4u sb[5]; pg8::bf16x8 a[8], an[8];
#define P5_LOADB(s_) do { _Pragma("unroll") for (int i = 0; i < 5; ++i) { const int p_ = tid + NWAVES * 64 * i; sb[i] = *(const v4u*)(WR + (size_t)(p_ >> 5) * D + (s_) * 256 + (p_ & 31) * 8); } } while (0)
#define P5_PUTB(buf_) do { _Pragma("unroll") for (int i = 0; i < 5; ++i) { const int p_ = tid + NWAVES * 64 * i; *(LAS v4u*)((buf_) + (p_ >> 5) * BP + (p_ & 31) * 8) = sb[i]; } } while (0)
#define P5_LOADA(dst_, s_) do { _Pragma("unroll") for (int u = 0; u < 8; ++u) dst_[u] = *(const pg8::bf16x8*)(ap + (s_) * 256 + 32 * u); } while (0)
            P5_LOADB(0); P5_LOADA(an, 0); P5_PUTB(Bs0);
            asm volatile("s_waitcnt lgkmcnt(0)" ::: "memory"); __builtin_amdgcn_s_barrier(); asm volatile("" ::: "memory");
#pragma unroll 1
            for (int sl = 0; sl < 8; ++sl) {
                LAS bf16* cur = (sl & 1) ? Bs1 : Bs0; LAS bf16* nxt = (sl & 1) ? Bs0 : Bs1;
#pragma unroll
                for (int u = 0; u < 8; ++u) a[u] = an[u];
                if (sl + 1 < 8) { P5_LOADB(sl + 1); P5_LOADA(an, sl + 1); }
                const LAS bf16* bp = cur + fr * BP + 8 * fg;
#pragma unroll
                for (int u = 0; u < 8; ++u)
#pragma unroll
                    for (int n = 0; n < 5; ++n) { const pg8::bf16x8 bq = *(const LAS pg8::bf16x8*)(bp + (16 * n) * BP + 32 * u); acc[n] = __builtin_amdgcn_mfma_f32_16x16x32_bf16(a[u], bq, acc[n], 0, 0, 0); }
                if (sl + 1 < 8) P5_PUTB(nxt);
                asm volatile("s_waitcnt lgkmcnt(0)" ::: "memory"); __builtin_amdgcn_s_barrier(); asm volatile("" ::: "memory");
            }
#undef P5_LOADB
#undef P5_PUTB
#undef P5_LOADA
            LAS float* LG = (LAS float*)(lds + 86016) + wave * (16 * 84);
#pragma unroll
            for (int n = 0; n < 5; ++n)
#pragma unroll
                for (int r = 0; r < 4; ++r) LG[(4 * fg + r) * 84 + 16 * n + fr] = acc[n][r];
            float rsl;
            { const f32x4* sp = (const f32x4*)(SSQ + (size_t)(row0 + fr) * 32); f32x4 a4 = sp[0];
#pragma unroll
              for (int q = 1; q < 8; ++q) a4 += sp[q];
              rsl = rsqrtf(((a4.x + a4.y) + (a4.z + a4.w)) * (1.f / 2048.f) + EPS); }
            LDS_WAIT(); asm volatile("" ::: "memory");
            int mycnt = 0;
#pragma unroll 1
            for (int rr = 0; rr < 16; ++rr) {
                const int t = row0 + rr; const float rs = __shfl(rsl, rr);
                const float gl = LG[rr * 84 + (lane & 7)] * rs + rgb[lane & 7], el = LG[rr * 84 + 8 + lane] * rs + reb[lane];
                float gm = gl; gm = fmaxf(gm, __shfl_xor(gm, 1)); gm = fmaxf(gm, __shfl_xor(gm, 2)); gm = fmaxf(gm, __shfl_xor(gm, 4));
                int gi = (gl == gm) ? (lane & 7) : 8; gi = min(gi, __shfl_xor(gi, 1)); gi = min(gi, __shfl_xor(gi, 2)); gi = min(gi, __shfl_xor(gi, 4));
                float gsum = __expf(gl - gm); gsum += __shfl_xor(gsum, 1); gsum += __shfl_xor(gsum, 2); gsum += __shfl_xor(gsum, 4);
                gi = __builtin_amdgcn_readfirstlane(gi); const float gwt = 1.0f / gsum;
                const float v = __shfl(el, gi * 8 + (lane & 7));
                float m1 = v; m1 = fmaxf(m1, __shfl_xor(m1, 1)); m1 = fmaxf(m1, __shfl_xor(m1, 2)); m1 = fmaxf(m1, __shfl_xor(m1, 4));
                int i1 = (v == m1) ? (lane & 7) : 8; i1 = min(i1, __shfl_xor(i1, 1)); i1 = min(i1, __shfl_xor(i1, 2)); i1 = min(i1, __shfl_xor(i1, 4));
                const float v2 = ((lane & 7) == i1) ? -3.0e38f : v;
                float m2 = v2; m2 = fmaxf(m2, __shfl_xor(m2, 1)); m2 = fmaxf(m2, __shfl_xor(m2, 2)); m2 = fmaxf(m2, __shfl_xor(m2, 4));
                int i2 = (v2 == m2) ? (lane & 7) : 8; i2 = min(i2, __shfl_xor(i2, 1)); i2 = min(i2, __shfl_xor(i2, 2)); i2 = min(i2, __shfl_xor(i2, 4));
                const float e2 = __expf(m2 - m1), inv = 1.0f / (1.0f + e2);
                const int e_a = gi * 8 + __builtin_amdgcn_readfirstlane(i1), e_b = gi * 8 + __builtin_amdgcn_readfirstlane(i2);
                mycnt += (lane == e_a) + (lane == e_b);
                if (lane == 0) { EID[t * 2] = e_a; EID[t * 2 + 1] = e_b; GATE[t * 2] = gwt * inv; GATE[t * 2 + 1] = gwt * e2 * inv; RSTD[t] = rs; }
            }
            if (mycnt) atomicAdd(&CNT[(row0 >> 8) * 64 + lane], mycnt);
            LDS_WAIT(); asm volatile("" ::: "memory");
        }
    }

    SEAM(5);
    PH_BEGIN(6)
        PHASE_IDS;
        if (blockIdx.x < T / 256) {
            const int w = blockIdx.x;
            LAS int* ptot = (LAS int*)lds; LAS int* pbef = ptot + 512; LAS int* basel = pbef + 512; LAS int* eidl = basel + 64; LAS int* posl = eidl + 512; LAS int* totl = posl + 512; LAS int* startl = totl + 64;
            { const int e = tid & 63, part = tid >> 6; int st = 0, sb = 0;
              for (int q = 0; q < 16; ++q) { const int wp = part * 16 + q; const int cv = CNT[wp * 64 + e]; st += cv; sb += (wp < w) ? cv : 0; }
              ptot[part * 64 + e] = st; pbef[part * 64 + e] = sb; }
            eidl[tid] = EID[w * 512 + tid];
            __syncthreads();
            if (wave == 0) {
                int tot = 0, bef = 0;
#pragma unroll
                for (int p = 0; p < 8; ++p) { tot += ptot[p * 64 + lane]; bef += pbef[p * 64 + lane]; }
                const int pc = ((tot + 255) >> 8) << 8; int incl = pc;
#pragma unroll
                for (int o = 1; o < 64; o <<= 1) { const int v = __shfl_up(incl, o); if (lane >= o) incl += v; }
                const int start = incl - pc;
                basel[lane] = start + bef; totl[lane] = tot; startl[lane] = start;
                if (w == 0) { for (int r = 0; r < (pc >> 8); ++r) TILES[64 + (start >> 8) + r] = lane; if (lane == 63) TILES[0] = incl >> 8; }
            }
            LAS int* wcnt = startl + 64;
            wcnt[tid] = 0;
            __syncthreads();
            const int mye = eidl[tid]; int rk = 0;
#pragma unroll 8
            for (int l = 0; l < 64; ++l) { const int el = __builtin_amdgcn_readlane(mye, l); rk += (l < lane && el == mye) ? 1 : 0; }
            atomicAdd((int*)&wcnt[wave * 64 + mye], 1);
            __syncthreads();
            { int off = 0;
              for (int w2 = 0; w2 < wave; ++w2) off += wcnt[w2 * 64 + mye];
              const int a = w * 512 + tid; const int p = basel[mye] + off + rk; ROWTOK[p] = a >> 1; ROWGATE[p] = GATE[a]; ROWSC[p] = RSTD[a >> 1]; POS[a] = p; }
            if (w < NE) { const int e = w; const int s0 = startl[e] + totl[e], s1 = startl[e] + (((totl[e] + 255) >> 8) << 8);
                for (int p = s0 + tid; p < s1; p += NWAVES * 64) { ROWTOK[p] = 0; ROWGATE[p] = 0.f; ROWSC[p] = 0.f; } }
        }
    }

    PH_BEGIN(7)
    }

    SEAM(7);
    PH_BEGIN(8)
        PHASE_IDS;
        LAS int* rt = (LAS int*)(lds + RING_BYTES);
        LAS float* rsc = (LAS float*)(lds + RING_BYTES + 8192);
        LAS int* te = (LAS int*)(lds + RING_BYTES + 16384);
        const int ntl = TILES[0];
        for (int i = tid; i < ntl; i += NWAVES * 64) te[i] = TILES[64 + i];
        __syncthreads();
        pg8::Gemm g{H1B, WGU, CAP_ROWS, NE * 1024, D}; pg8::MoeOrder S{te, ntl, 4, G, (int)blockIdx.x, 48, 64};
        { pg8::Unit uu; for (int i = 0; i < 8 && S.next(i, uu); ++i) { if (tid < 256) rt[i * 256 + tid] = ROWTOK[uu.pm * 256 + tid]; else rsc[i * 256 + tid - 256] = ROWSC[uu.pm * 256 + tid - 256]; } }
        __syncthreads();
        pg8::EpiSwiGLU E{HID, rsc};
        pg8::gemm_phase<pg8::EpiSwiGLU, pg8::MoeOrder, PG8_ALIGN, PG8_SP2, true>(lds + RING_OFF, g, S, E, wave, rt);
    }
    SEAM(8);
    PH_BEGIN(9)
        PHASE_IDS;
        LAS float* rgt = (LAS float*)(lds + RING_BYTES);
        LAS int* te = (LAS int*)(lds + RING_BYTES + 16384);
        const int ntl = TILES[0];
        for (int i = tid; i < ntl; i += NWAVES * 64) te[i] = TILES[64 + i];
        __syncthreads();
        pg8::Gemm g{HID, WDN, CAP_ROWS, NE * 2048, DE}; pg8::MoeOrder S{te, ntl, 8, G, (int)blockIdx.x, 1 << 30, 0};
        { pg8::Unit uu; for (int i = 0; i < 12 && S.next(i, uu); ++i) { if (tid < 256) rgt[i * 256 + tid] = ROWGATE[uu.pm * 256 + tid]; } }
        __syncthreads();
        pg8::EpiDown E{YMOE, rgt};
        pg8::gemm_phase<pg8::EpiDown, pg8::MoeOrder, PG8_ALIGN, PG8_SP2>(lds + RING_OFF, g, S, E, wave);
    }
    SEAM(9);
    PH_BEGIN(10)
        PHASE_IDS;
        {
            v2u na[8], nb[8], nh[8]; int q0 = 0, q1 = 0;
            f32x4 fwv[8];
#pragma unroll
            for (int j = 0; j < 8; ++j) fwv[j] = *((const f32x4*)final_w + lane + 64 * j);
#define P10_LOAD(tt, p0_, p1_) do { const v2u* hb_ = (const v2u*)(H1B + (size_t)(tt) * D) + lane; const v2u* y0_ = (const v2u*)(YMOE + (size_t)(p0_) * D) + lane; const v2u* y1_ = (const v2u*)(YMOE + (size_t)(p1_) * D) + lane; \
        _Pragma("unroll") for (int j = 0; j < 8; ++j) { na[j] = y0_[64 * j]; nb[j] = y1_[64 * j]; nh[j] = hb_[64 * j]; } } while (0)
            if (gw < T) { P10_LOAD(gw, POS[gw * 2], POS[gw * 2 + 1]); }
            if (gw + NGW < T) { q0 = POS[(gw + NGW) * 2]; q1 = POS[(gw + NGW) * 2 + 1]; }
            for (int t = gw; t < T; t += NGW) {
                f32x4 v[8]; float ss = 0.f;
#pragma unroll
                for (int j = 0; j < 8; ++j) { const v2u a = na[j], b = nb[j], hh = nh[j];
                    v[j].x = bflo(hh.x) + (bflo(a.x) + bflo(b.x)); v[j].y = bfhi(hh.x) + (bfhi(a.x) + bfhi(b.x)); v[j].z = bflo(hh.y) + (bflo(a.y) + bflo(b.y)); v[j].w = bfhi(hh.y) + (bfhi(a.y) + bfhi(b.y));
                    ss += (v[j].x * v[j].x + v[j].y * v[j].y) + (v[j].z * v[j].z + v[j].w * v[j].w); }
                if (t + NGW < T) { P10_LOAD(t + NGW, q0, q1); }
                if (t + 2 * NGW < T) { q0 = POS[(t + 2 * NGW) * 2]; q1 = POS[(t + 2 * NGW) * 2 + 1]; }
                const float rstd = rsqrtf(wave_sum(ss) * (1.f / D) + EPS);
                f32x4* hr = (f32x4*)(out + (size_t)t * D) + lane;
#pragma unroll
                for (int j = 0; j < 8; ++j) hr[64 * j] = v[j] * rstd * fwv[j];
            }
#undef P10_LOAD
        }
    }
#undef IN
#undef SEAM
}

template <unsigned PM> static bool setup_kernel(int& per_cu) {
    if (hipFuncSetAttribute((const void*)fwd<PM>, hipFuncAttributeMaxDynamicSharedMemorySize, LDS_BYTES) != hipSuccess) return false;
    int pc = 0; if (hipOccupancyMaxActiveBlocksPerMultiprocessor(&pc, (const void*)fwd<PM>, NWAVES * 64, LDS_BYTES) != hipSuccess) pc = 0;
    per_cu = pc; (void)hipGetLastError(); return true;
}
template <unsigned PM> static void launch_phase(int grid, hipStream_t stream, Args a, int ph) { a.ph_lo = ph; a.ph_hi = ph + 1; hipLaunchKernelGGL(fwd<PM>, dim3(grid), dim3(NWAVES * 64), LDS_BYTES, stream, a); }
extern "C" void kernel_launch(void* const* d_in, const int* in_sizes, int n_in, void* d_out, int out_size, void* d_ws, size_t ws_size, hipStream_t stream) {
    static int grid = 0;
    if (grid == 0) {
        if (n_in != 18 || in_sizes[0] != T * D || out_size != T * D || ws_size < WS_END) { fprintf(stderr, "kernel_launch: unexpected shapes (n_in %d, in0 %d, out %d, ws %zu); nothing launched\n", n_in, n_in > 0 ? in_sizes[0] : -1, out_size, ws_size); grid = -1; return; }
        int dev = 0, cus = 0, per_cu = 0;
        if (hipGetDevice(&dev) != hipSuccess || hipDeviceGetAttribute(&cus, hipDeviceAttributeMultiprocessorCount, dev) != hipSuccess) { grid = -1; return; }
        bool ok = setup_kernel<0x7FFu>(per_cu);
        if (!ok) { fprintf(stderr, "kernel_launch: hipFuncSetAttribute failed\n"); grid = -1; return; }
        grid = cus;
    }
    if (grid < 0) return;
    if (hipMemsetAsync((char*)d_ws + WS_CTL, 0, CTL_ZERO_BYTES, stream) != hipSuccess) return;
    Args a{};
    for (int i = 0; i < 18; ++i) a.in[i] = (const float*)d_in[i];
    a.out = (float*)d_out; a.ws = (unsigned char*)d_ws;
    a.ph_lo = 0; a.ph_hi = N_PHASES;
    hipLaunchKernelGGL(fwd<0x7FFu>, dim3(grid), dim3(NWAVES * 64), LDS_BYTES, stream, a);
}
```
